# Optimizing an MI355X kernel written in HIP

```python
import jax, jax.numpy as jnp
from jax import lax
import numpy as np

D_MODEL = 1024
BATCH = 8
SEQ = 4096
DEPTH = 1

CTX_LEN = 256
GRID_W = 64
ROPE_BASE = 10000.0
EPS = 1e-6
NEG_INF = -1e30

MLA_HEADS = 8
MLA_Q_RANK = 256
MLA_KV_RANK = 128
MLA_NOPE = 64
MLA_ROPE = 32
MLA_V = 64
MLA_SCALE = (MLA_NOPE + MLA_ROPE) ** -0.5

SWA_HEADS = 8
SWA_KV_HEADS = 2
SWA_HEAD_DIM = 64
WINDOW = 128
BLOCK = 128
SWA_SCALE = SWA_HEAD_DIM ** -0.5

D_FF = 2816
CONV_W = 3

W_QA = MLA_Q_RANK
W_KVA = MLA_KV_RANK
W_KR = MLA_ROPE
W_SQ = SWA_HEADS * SWA_HEAD_DIM
W_SKV = SWA_KV_HEADS * SWA_HEAD_DIM
W_GATE = 2 * D_MODEL
D_IN = W_QA + W_KVA + W_KR + W_SQ + 2 * W_SKV + W_GATE
SPLITS = (W_QA, W_QA + W_KVA, W_QA + W_KVA + W_KR, W_QA + W_KVA + W_KR + W_SQ,
          W_QA + W_KVA + W_KR + W_SQ + W_SKV, W_QA + W_KVA + W_KR + W_SQ + 2 * W_SKV)

kernel_name = 'hybrid_mla_swa_convffn_dit_block'


def rmsnorm(x, g):
    xf = x.astype(jnp.float32)
    y = xf * lax.rsqrt(jnp.mean(xf * xf, axis=-1, keepdims=True) + EPS)
    return (y * g.astype(jnp.float32)).astype(x.dtype)


def modulate(h, shift, scale):
    return h * (1 + scale[:, None, :]) + shift[:, None, :]


def rope_tables(s_len, rot_dim, dtype):
    rows = s_len // GRID_W
    row = jnp.repeat(jnp.arange(rows, dtype=jnp.float32), GRID_W)
    col = jnp.tile(jnp.arange(GRID_W, dtype=jnp.float32), rows)
    quarter = rot_dim // 4
    inv = ROPE_BASE ** (-jnp.arange(quarter, dtype=jnp.float32) / quarter)
    ar = row[:, None] * inv
    ac = col[:, None] * inv
    ang = jnp.concatenate([ar, ar, ac, ac], axis=-1)
    return jnp.cos(ang).astype(dtype), jnp.sin(ang).astype(dtype)


def apply_rope(x, cos, sin):
    q1, q2, q3, q4 = jnp.split(x, 4, axis=-1)
    rot = jnp.concatenate([-q2, q1, -q4, q3], axis=-1)
    return x * cos[None, :, None, :] + rot * sin[None, :, None, :]


def dense_attention(q, k, v, scale):
    s = jnp.einsum('bqhd,bkhd->bhqk', q, k).astype(jnp.float32) * scale
    p = jax.nn.softmax(s, axis=-1).astype(v.dtype)
    return jnp.einsum('bhqk,bkhd->bqhd', p, v)


def mla_heads(q_a, kv_a, k_r, q_norm_g, w_q_up, kv_norm_g, w_kv_up, rope):
    b, L, _ = q_a.shape
    q = (rmsnorm(q_a, q_norm_g) @ w_q_up).reshape(b, L, MLA_HEADS, MLA_NOPE + MLA_ROPE)
    q_nope, q_rope = q[..., :MLA_NOPE], q[..., MLA_NOPE:]
    kv = (rmsnorm(kv_a, kv_norm_g) @ w_kv_up).reshape(b, L, MLA_HEADS, MLA_NOPE + MLA_V)
    k_nope, v = kv[..., :MLA_NOPE], kv[..., MLA_NOPE:]
    k_rope = k_r.reshape(b, L, 1, MLA_ROPE)
    if rope is not None:
        cos, sin = rope
        q_rope = apply_rope(q_rope, cos, sin)
        k_rope = apply_rope(k_rope, cos, sin)
    k = jnp.concatenate([k_nope, jnp.broadcast_to(k_rope, (b, L, MLA_HEADS, MLA_ROPE))], axis=-1)
    q = jnp.concatenate([q_nope, q_rope], axis=-1)
    return q, k, v


def swa_heads(q_s, k_s, v_s, rope):
    b, L, _ = q_s.shape
    q = q_s.reshape(b, L, SWA_HEADS, SWA_HEAD_DIM)
    k = k_s.reshape(b, L, SWA_KV_HEADS, SWA_HEAD_DIM)
    v = v_s.reshape(b, L, SWA_KV_HEADS, SWA_HEAD_DIM)
    if rope is not None:
        cos, sin = rope
        q = apply_rope(q, cos, sin)
        k = apply_rope(k, cos, sin)
    return q, k, v


def mla_latent(q, k_all, v_all):
    b, s, h, dq = q.shape
    nb = s // BLOCK
    qb = q.reshape(b, nb, BLOCK, h, dq).transpose(1, 0, 2, 3, 4)
    out = lax.map(lambda qblk: dense_attention(qblk, k_all, v_all, MLA_SCALE), qb)
    return out.transpose(1, 0, 2, 3, 4).reshape(b, s, h * v_all.shape[-1])


def swa_latent(q, k, v, k_ctx, v_ctx, sink):
    b, s, hq, d = q.shape
    hkv = k.shape[2]
    g = hq // hkv
    nb = s // BLOCK
    c_len = k_ctx.shape[1]
    qb = q.reshape(b, nb, BLOCK, hkv, g, d)

    def band(t):
        tp = jnp.pad(t, ((0, 0), (BLOCK, BLOCK), (0, 0), (0, 0))).reshape(b, nb + 2, BLOCK, hkv, d)
        return jnp.concatenate([tp[:, :-2], tp[:, 1:-1], tp[:, 2:]], axis=2)

    kb, vb = band(k), band(v)
    rel = jnp.arange(3 * BLOCK)[None, :] - BLOCK - jnp.arange(BLOCK)[:, None]
    key_pos = jnp.arange(nb)[:, None] * BLOCK - BLOCK + jnp.arange(3 * BLOCK)[None, :]
    mask = (jnp.abs(rel) <= WINDOW)[None, :, :] & ((key_pos >= 0) & (key_pos < s))[:, None, :]
    s_loc = jnp.einsum('bnqhgd,bnkhd->bnhgqk', qb, kb).astype(jnp.float32) * SWA_SCALE
    s_loc = jnp.where(mask[None, :, None, None], s_loc, NEG_INF)
    s_ctx = jnp.einsum('bnqhgd,bkhd->bnhgqk', qb, k_ctx).astype(jnp.float32) * SWA_SCALE
    sink_l = jnp.broadcast_to(sink.astype(jnp.float32).reshape(1, 1, hkv, g, 1, 1), s_loc.shape[:-1] + (1,))
    p = jax.nn.softmax(jnp.concatenate([s_loc, s_ctx, sink_l], axis=-1), axis=-1).astype(v.dtype)
    p_loc = p[..., :3 * BLOCK]
    p_ctx = p[..., 3 * BLOCK:3 * BLOCK + c_len]
    out = (jnp.einsum('bnhgqk,bnkhd->bnqhgd', p_loc, vb)
           + jnp.einsum('bnhgqk,bkhd->bnqhgd', p_ctx, v_ctx))
    return out.reshape(b, s, hq * d)


def swa_context(q, k, v, sink):
    b, c_len, hq, d = q.shape
    hkv = k.shape[2]
    g = hq // hkv
    qg = q.reshape(b, c_len, hkv, g, d)
    s = jnp.einsum('bqhgd,bkhd->bhgqk', qg, k).astype(jnp.float32) * SWA_SCALE
    sink_l = jnp.broadcast_to(sink.astype(jnp.float32).reshape(1, hkv, g, 1, 1), s.shape[:-1] + (1,))
    p = jax.nn.softmax(jnp.concatenate([s, sink_l], axis=-1), axis=-1)[..., :-1].astype(v.dtype)
    return jnp.einsum('bhgqk,bkhd->bqhgd', p, v).reshape(b, c_len, hq * d)


def merge_branches(o_mla, o_swa, gate_logits, b_gate, w_o_mla, w_o_swa, w_out):
    gates = jax.nn.sigmoid(gate_logits + b_gate)
    g_a, g_b = jnp.split(gates, 2, axis=-1)
    return (g_a * (o_mla @ w_o_mla) + g_b * (o_swa @ w_o_swa)) @ w_out


def dwconv(u, w, bias):
    L = u.shape[1]
    pad = CONV_W // 2
    up = jnp.pad(u, ((0, 0), (pad, pad), (0, 0)))
    out = bias
    for j in range(CONV_W):
        out = out + up[:, j:j + L] * w[j]
    return out


def conv_ffn(h, w_up, conv_w, conv_b, w_down):
    u = dwconv(h @ w_up, conv_w, conv_b)
    gate, val = jnp.split(u, 2, axis=-1)
    return (jax.nn.silu(gate) * val) @ w_down


def setup_inputs(seed: int = 0) -> dict:
    key = jax.random.key(seed)
    ks = jax.random.split(key, 24)
    f32 = jnp.float32

    def w(k, shape, fan_in):
        return jax.random.normal(k, shape, f32) * fan_in ** -0.5

    def gain(k, n):
        return 1.0 + 0.1 * jax.random.normal(k, (DEPTH, n), f32)

    return {
        'x': jax.random.normal(ks[0], (BATCH, SEQ, D_MODEL), f32),
        'c': jax.random.normal(ks[1], (BATCH, D_MODEL), f32),
        'ctx': jax.random.normal(ks[2], (BATCH, CTX_LEN, D_MODEL), f32),
        'c_ctx': jax.random.normal(ks[3], (D_MODEL,), f32),
        'w_ada': w(ks[4], (DEPTH, D_MODEL, 6 * D_MODEL), D_MODEL),
        'b_ada': 0.02 * jax.random.normal(ks[5], (DEPTH, 6 * D_MODEL), f32),
        'attn_pre_g': gain(ks[6], D_MODEL),
        'attn_post_g': gain(ks[7], D_MODEL),
        'w_in': w(ks[8], (DEPTH, D_MODEL, D_IN), D_MODEL),
        'b_gate': 0.02 * jax.random.normal(ks[9], (DEPTH, W_GATE), f32),
        'mla_q_norm_g': gain(ks[10], MLA_Q_RANK),
        'mla_w_q_up': w(ks[11], (DEPTH, MLA_Q_RANK, MLA_HEADS * (MLA_NOPE + MLA_ROPE)), MLA_Q_RANK),
        'mla_kv_norm_g': gain(ks[12], MLA_KV_RANK),
        'mla_w_kv_up': w(ks[13], (DEPTH, MLA_KV_RANK, MLA_HEADS * (MLA_NOPE + MLA_V)), MLA_KV_RANK),
        'mla_w_o': w(ks[14], (DEPTH, MLA_HEADS * MLA_V, D_MODEL), MLA_HEADS * MLA_V),
        'swa_sink': 0.5 * jax.random.normal(ks[15], (DEPTH, SWA_HEADS), f32),
        'swa_w_o': w(ks[16], (DEPTH, SWA_HEADS * SWA_HEAD_DIM, D_MODEL), SWA_HEADS * SWA_HEAD_DIM),
        'w_out': w(ks[17], (DEPTH, D_MODEL, D_MODEL), D_MODEL),
        'ffn_pre_g': gain(ks[18], D_MODEL),
        'ffn_post_g': gain(ks[19], D_MODEL),
        'ffn_w_up': w(ks[20], (DEPTH, D_MODEL, 2 * D_FF), D_MODEL),
        'ffn_conv_w': w(ks[21], (DEPTH, CONV_W, 2 * D_FF), CONV_W),
        'ffn_conv_b': 0.02 * jax.random.normal(ks[22], (DEPTH, 2 * D_FF), f32),
        'ffn_w_down': w(ks[23], (DEPTH, D_FF, D_MODEL), D_FF),
    }


def reference(x, c, ctx, c_ctx, w_ada, b_ada, attn_pre_g, attn_post_g, w_in, b_gate,
              mla_q_norm_g, mla_w_q_up, mla_kv_norm_g, mla_w_kv_up, mla_w_o, swa_sink, swa_w_o,
              w_out, ffn_pre_g, ffn_post_g, ffn_w_up, ffn_conv_w, ffn_conv_b, ffn_w_down):
    s_len = x.shape[1]
    rope_mla = rope_tables(s_len, MLA_ROPE, x.dtype)
    rope_swa = rope_tables(s_len, SWA_HEAD_DIM, x.dtype)
    xc = ctx
    for l in range(DEPTH):
        last = l == DEPTH - 1
        mod = jax.nn.silu(c) @ w_ada[l] + b_ada[l]
        mod_c = (jax.nn.silu(c_ctx) @ w_ada[l] + b_ada[l])[None]
        sh1, sc1, g1, sh2, sc2, g2 = jnp.split(mod, 6, axis=-1)
        csh1, csc1, cg1, csh2, csc2, cg2 = jnp.split(mod_c, 6, axis=-1)

        h_lat = modulate(rmsnorm(x, attn_pre_g[l]), sh1, sc1)
        h_ctx = modulate(rmsnorm(xc, attn_pre_g[l]), csh1, csc1)
        p_lat = jnp.split(h_lat @ w_in[l], SPLITS, axis=-1)
        p_ctx = jnp.split(h_ctx @ w_in[l], SPLITS, axis=-1)

        q_ml, k_ml, v_ml = mla_heads(p_lat[0], p_lat[1], p_lat[2], mla_q_norm_g[l], mla_w_q_up[l],
                                     mla_kv_norm_g[l], mla_w_kv_up[l], rope_mla)
        q_mc, k_mc, v_mc = mla_heads(p_ctx[0], p_ctx[1], p_ctx[2], mla_q_norm_g[l], mla_w_q_up[l],
                                     mla_kv_norm_g[l], mla_w_kv_up[l], None)
        q_sl, k_sl, v_sl = swa_heads(p_lat[3], p_lat[4], p_lat[5], rope_swa)
        q_sc, k_sc, v_sc = swa_heads(p_ctx[3], p_ctx[4], p_ctx[5], None)

        o_mla_l = mla_latent(q_ml, jnp.concatenate([k_mc, k_ml], axis=1), jnp.concatenate([v_mc, v_ml], axis=1))
        o_swa_l = swa_latent(q_sl, k_sl, v_sl, k_sc, v_sc, swa_sink[l])
        attn_l = merge_branches(o_mla_l, o_swa_l, p_lat[6], b_gate[l], mla_w_o[l], swa_w_o[l], w_out[l])
        x = x + g1[:, None, :] * rmsnorm(attn_l, attn_post_g[l])

        if not last:
            b, c_len = xc.shape[0], xc.shape[1]
            o_mla_c = dense_attention(q_mc, k_mc, v_mc, MLA_SCALE).reshape(b, c_len, MLA_HEADS * MLA_V)
            o_swa_c = swa_context(q_sc, k_sc, v_sc, swa_sink[l])
            attn_c = merge_branches(o_mla_c, o_swa_c, p_ctx[6], b_gate[l], mla_w_o[l], swa_w_o[l], w_out[l])
            xc = xc + cg1[:, None, :] * rmsnorm(attn_c, attn_post_g[l])
            hf_c = modulate(rmsnorm(xc, ffn_pre_g[l]), csh2, csc2)
            f_c = conv_ffn(hf_c, ffn_w_up[l], ffn_conv_w[l], ffn_conv_b[l], ffn_w_down[l])
            xc = xc + cg2[:, None, :] * rmsnorm(f_c, ffn_post_g[l])

        hf = modulate(rmsnorm(x, ffn_pre_g[l]), sh2, sc2)
        f = conv_ffn(hf, ffn_w_up[l], ffn_conv_w[l], ffn_conv_b[l], ffn_w_down[l])
        x = x + g2[:, None, :] * rmsnorm(f, ffn_post_g[l])
    return x
```

```cpp
#include <hip/hip_runtime.h>
#include <hip/hip_bf16.h>
#include <cstdio>
#include <cstdint>
#include <cmath>
namespace pg8 {
#define PG8_LAS __attribute__((address_space(3)))
typedef unsigned short bf16_t;
typedef short bf16x8 __attribute__((ext_vector_type(8)));
typedef float f32x4 __attribute__((ext_vector_type(4)));
typedef unsigned u32x4 __attribute__((ext_vector_type(4)));
typedef unsigned u32x2 __attribute__((ext_vector_type(2)));
constexpr int BM = 256, BK = 64, HALF = 128, HTB = HALF * BK * 2, STAGE_BYTES = 8 * HTB, NXCD = 8, WGM = 8;

__host__ __device__ __forceinline__ int lds_byte(int r, int c) { const int st = (r >> 4) * 2 + (c >> 5), rr = r & 15, cc = c & 31, ob = rr * 64 + cc * 2; return st * 1024 + (ob ^ (((ob >> 9) & 1) << 5)); }
__host__ __device__ __forceinline__ void stage_rc(int b, int& R, int& C) { const int st = b / 1024, sb = b % 1024, swz = sb ^ (((sb >> 9) & 1) << 5); R = (st >> 1) * 16 + swz / 64; C = (st & 1) * 32 + (swz % 64) / 2; }

struct Unit { int pm, pn; };
struct Gemm { const bf16_t* A; const bf16_t* Bt; int lda, ldb, K; };

__device__ __forceinline__ bool static_unit(int nM, int nN, long L, Unit& u) {
    const int nwg = nM * nN; if (L >= nwg) return false;
    int wgid = (int)L; { const int q = nwg / NXCD, r = nwg % NXCD, xcd = wgid % NXCD, off = wgid / NXCD; wgid = (xcd < r ? xcd * (q + 1) : r * (q + 1) + (xcd - r) * q) + off; }
    const int nig = WGM * nN, gid = wgid / nig, fm = gid * WGM, gsz = (nM - fm) < WGM ? (nM - fm) : WGM;
    u.pm = fm + ((wgid % nig) % gsz); u.pn = (wgid % nig) / gsz; return true;
}
template <int MODE> struct Order {
    int nN, G, c;
    __device__ __forceinline__ bool next(int i, Unit& u) const {
        const long L = (long)i * G + c;
        if (MODE == 0) return static_unit(136, nN, L, u);
        if (MODE == 1) { if (!static_unit(128, nN, L, u)) return false; u.pm = (u.pm >> 4) * 17 + 1 + (u.pm & 15); return true; }
        if (static_unit(128, 13, L, u)) { u.pm = (u.pm >> 4) * 17 + 1 + (u.pm & 15); return true; }
        const long e = L - 128 * 13; if (e >= 16) return false;
        u.pm = (int)(e >> 1) * 17; u.pn = 1 + (int)(e & 1); return true;
    }
};

template <class Epi, class Sched>
__device__ __forceinline__ void gemm_phase(PG8_LAS unsigned char* lds, const Gemm g, const Sched& S, const Epi& E, int tid_in) {
    int tid_ = tid_in; asm volatile("" : "+v"(tid_));
    const int tid = tid_, wid = __builtin_amdgcn_readfirstlane(tid >> 6), lane = tid & 63, wr = wid >> 2, wc = wid & 3, fr = lane & 15, fq = lane >> 4;
    const int K = g.K, nt = K / BK;
    unsigned voffA[2], voffB[2];
#pragma unroll
    for (int i = 0; i < 2; ++i) { int R, C; stage_rc(tid * 16 + i * 8192, R, C);
        voffA[i] = (unsigned)(R * g.lda + C) * 2u; voffB[i] = (unsigned)(R * g.ldb + C) * 2u; }
    const size_t kstep = (size_t)(BK * 2);
    const size_t hstepA = (size_t)HALF * g.lda * 2, hstepB = (size_t)HALF * g.ldb * 2;
    const size_t tstepA = 2 * hstepA, tstepB = 2 * hstepB;
    const unsigned ldsw = (unsigned)wid * 1024u;
    const int aoff = lds_byte(wr * 64 + fr, fq * 8), boff = lds_byte(wc * 32 + fr, fq * 8);
#define PG8_SA(b, h) (((b) * 2 + (h)) * HTB)
#define PG8_SB(b, h) ((4 + (b) * 2 + (h)) * HTB)
#define PG8_STAGE(bufoff, gbase, voff) do { _Pragma("unroll") for (int _i = 0; _i < 2; ++_i) \
        __builtin_amdgcn_global_load_lds((const unsigned*)((const char*)(gbase) + (voff)[_i]), (PG8_LAS unsigned*)(lds + (bufoff) + ldsw + _i * 8192), 16, 0, 0); } while (0)
#define PG8_LDA(dst, b, h) do { _Pragma("unroll") for (int m = 0; m < 4; ++m) _Pragma("unroll") for (int k = 0; k < 2; ++k) dst[m][k] = *(const PG8_LAS bf16x8*)(lds + PG8_SA(b, h) + aoff + m * 2048 + k * 1024); } while (0)
#define PG8_LDB(dst, b, h) do { _Pragma("unroll") for (int n = 0; n < 2; ++n) _Pragma("unroll") for (int k = 0; k < 2; ++k) dst[n][k] = *(const PG8_LAS bf16x8*)(lds + PG8_SB(b, h) + boff + n * 2048 + k * 1024); } while (0)
#define PG8_MMA(ai, bj, At, Bt) do { __builtin_amdgcn_s_setprio(1); _Pragma("unroll") for (int m = 0; m < 4; ++m) _Pragma("unroll") for (int n = 0; n < 2; ++n) _Pragma("unroll") for (int k = 0; k < 2; ++k) \
        acc[ai][bj][m][n] = __builtin_amdgcn_mfma_f32_16x16x32_bf16(Bt[n][k], At[m][k], acc[ai][bj][m][n], 0, 0, 0); __builtin_amdgcn_s_setprio(0); } while (0)
#define PG8_WAIT_V(n) asm volatile("s_waitcnt vmcnt(" #n ")" ::: "memory")
#define PG8_WAIT_L(n) asm volatile("s_waitcnt lgkmcnt(" #n ")" ::: "memory")
#define PG8_BAR __builtin_amdgcn_s_barrier()
#define PG8_SCHED __builtin_amdgcn_sched_barrier(0)
    Unit cur, nxt; int ui = 0;
    if (!S.next(0, cur)) return;
    f32x4 acc[2][2][4][2];
#pragma unroll
    for (int a = 0; a < 2; ++a)
#pragma unroll
        for (int b = 0; b < 2; ++b)
#pragma unroll
            for (int m = 0; m < 4; ++m)
#pragma unroll
                for (int n = 0; n < 2; ++n) acc[a][b][m][n] = (f32x4){0.f, 0.f, 0.f, 0.f};
    bf16x8 At[4][2], B0[2][2], B1[2][2];
    const char* cA = (const char*)g.A + (size_t)cur.pm * tstepA; const char* cB = (const char*)g.Bt + (size_t)cur.pn * tstepB;
    PG8_STAGE(PG8_SB(0, 0), cB, voffB); PG8_STAGE(PG8_SB(0, 1), cB + hstepB, voffB); PG8_STAGE(PG8_SA(0, 0), cA, voffA); PG8_STAGE(PG8_SA(0, 1), cA + hstepA, voffA);
    if (wr == 1) PG8_BAR;
    PG8_WAIT_V(2); PG8_BAR;
    PG8_STAGE(PG8_SB(1, 0), cB + kstep, voffB); PG8_STAGE(PG8_SA(1, 0), cA + kstep, voffA); PG8_STAGE(PG8_SB(1, 1), cB + hstepB + kstep, voffB);
    PG8_WAIT_V(6); PG8_BAR;
    for (;;) {
        const bool has_next = S.next(ui + 1, nxt);
        const char* nA = has_next ? (const char*)g.A + (size_t)nxt.pm * tstepA : cA; const char* nB = has_next ? (const char*)g.Bt + (size_t)nxt.pn * tstepB : cB;
        for (int t = 0; t < nt; t += 2) {
            const bool last = (t == nt - 2);
            const char* a1 = cA + (size_t)(t + 1) * kstep;
            const char* a2 = last ? nA : cA + (size_t)(t + 2) * kstep; const char* b2 = last ? nB : cB + (size_t)(t + 2) * kstep;
            const char* a3 = a2 + kstep; const char* b3 = b2 + kstep;
            PG8_LDB(B0, 0, 0); PG8_LDB(B1, 0, 1); PG8_SCHED; PG8_LDA(At, 0, 0); PG8_STAGE(PG8_SA(1, 1), a1 + hstepA, voffA);
            PG8_WAIT_V(8); PG8_WAIT_L(0); PG8_BAR; PG8_MMA(0, 0, At, B0); PG8_MMA(0, 1, At, B1); PG8_BAR; PG8_SCHED;
            PG8_LDA(At, 0, 1); PG8_STAGE(PG8_SB(0, 0), b2, voffB); PG8_STAGE(PG8_SB(0, 1), b2 + hstepB, voffB); PG8_STAGE(PG8_SA(0, 0), a2, voffA);
            PG8_WAIT_V(8); PG8_WAIT_L(0); PG8_BAR; PG8_MMA(1, 0, At, B0); PG8_MMA(1, 1, At, B1); PG8_BAR; PG8_SCHED;
            PG8_LDB(B0, 1, 0); PG8_LDB(B1, 1, 1); PG8_SCHED; PG8_LDA(At, 1, 0); PG8_STAGE(PG8_SA(0, 1), a2 + hstepA, voffA);
            PG8_WAIT_V(8); PG8_WAIT_L(0); PG8_BAR; PG8_MMA(0, 0, At, B0); PG8_MMA(0, 1, At, B1); PG8_BAR; PG8_SCHED;
            PG8_LDA(At, 1, 1); PG8_STAGE(PG8_SB(1, 0), b3, voffB); PG8_STAGE(PG8_SB(1, 1), b3 + hstepB, voffB); PG8_STAGE(PG8_SA(1, 0), a3, voffA);
            PG8_WAIT_V(8); PG8_WAIT_L(0); PG8_BAR; PG8_MMA(1, 0, At, B0); PG8_MMA(1, 1, At, B1); PG8_BAR; PG8_SCHED;
        }
        if (wr == 0) PG8_BAR;
        { int fr_ = fr, fq_ = fq; asm volatile("" : "+v"(fr_), "+v"(fq_));
          E(acc, cur, wr, wc, fr_, fq_); }
        if (!has_next) break;
#pragma unroll
        for (int a = 0; a < 2; ++a)
#pragma unroll
            for (int b = 0; b < 2; ++b)
#pragma unroll
                for (int m = 0; m < 4; ++m)
#pragma unroll
                    for (int n = 0; n < 2; ++n) acc[a][b][m][n] = (f32x4){0.f, 0.f, 0.f, 0.f};
        cur = nxt; cA = nA; cB = nB; ++ui;
        if (wr == 1) PG8_BAR;
    }
    PG8_WAIT_V(0);
    PG8_BAR;
#undef PG8_SA
#undef PG8_SB
#undef PG8_STAGE
#undef PG8_LDA
#undef PG8_LDB
#undef PG8_MMA
#undef PG8_WAIT_V
#undef PG8_WAIT_L
#undef PG8_BAR
#undef PG8_SCHED
}
}
namespace att {
typedef unsigned short bf16_t;
using bf16x8 = __attribute__((ext_vector_type(8))) short;
using s16x4  = __attribute__((ext_vector_type(4))) short;
using f32x16 = __attribute__((ext_vector_type(16))) float;
using u32x4  = __attribute__((ext_vector_type(4))) unsigned;
constexpr int NW = 8, QBLK = 32, KVBLK = 64;
constexpr int SHM_V = 64 * 128 * 2, SHM_K = 64 * 128 * 2;
constexpr int OFF_V = 0, OFF_K = 2 * SHM_V, OFF_WS = OFF_K + 2 * SHM_K, OFF_OST = OFF_WS + NW * 64 * 4, ATT_LDS = OFF_OST + NW * 4096;
#define KSWZ(row, colB) ((row) * 256 + ((colB) ^ (((row) & 7) << 4)))
#define SBAR() __builtin_amdgcn_sched_barrier(0)
__device__ __forceinline__ int crow(int r, int hi) { return (r & 3) + 8 * (r >> 2) + 4 * hi; }
typedef float f32x2_t __attribute__((ext_vector_type(2))); typedef __bf16 bf16x2_t __attribute__((ext_vector_type(2)));
__device__ __forceinline__ unsigned cvtpk(float lo, float hi) { f32x2_t v = {lo, hi}; bf16x2_t b = __builtin_convertvector(v, bf16x2_t); return __builtin_bit_cast(unsigned, b); }

template <int SC1000000  > struct Dummy {};

__device__ __forceinline__ void partialSM(f32x16& p0, f32x16& p1, float& m_reg, float& mn, float& alpha, const float C, const float THRS) {
  float pmax = p0[0];
#pragma unroll
  for (int r = 1; r < 16; ++r) pmax = fmaxf(pmax, p0[r]);
#pragma unroll
  for (int r = 0; r < 16; ++r) pmax = fmaxf(pmax, p1[r]);
  { auto rr = __builtin_amdgcn_permlane32_swap(__float_as_uint(pmax), __float_as_uint(pmax), false, false);
    pmax = fmaxf(__uint_as_float(rr[0]), __uint_as_float(rr[1])); }
  if (__builtin_expect(__all(pmax - m_reg <= THRS), 1)) { mn = m_reg; alpha = 1.f; }
  else { mn = fmaxf(m_reg, pmax); alpha = __builtin_amdgcn_exp2f((m_reg - mn) * C); m_reg = mn; }
  float mnC = -mn * C;
#pragma unroll
  for (int r = 0; r < 16; ++r) p0[r] = fmaf(p0[r], C, mnC);
#pragma unroll
  for (int r = 0; r < 16; ++r) p1[r] = fmaf(p1[r], C, mnC);
#pragma unroll
  for (int r = 0; r < 16; ++r) p0[r] = __builtin_amdgcn_exp2f(p0[r]);
}
__device__ __forceinline__ void finishSM(f32x16& p0, f32x16& p1, float alpha, float& l_reg, bf16x8& pa0, bf16x8& pa1, bf16x8& pa2, bf16x8& pa3) {
#pragma unroll
  for (int r = 0; r < 16; ++r) p1[r] = __builtin_amdgcn_exp2f(p1[r]);
  float ps = 0;
#pragma unroll
  for (int r = 0; r < 16; ++r) ps += p0[r];
#pragma unroll
  for (int r = 0; r < 16; ++r) ps += p1[r];
  { auto rr = __builtin_amdgcn_permlane32_swap(__float_as_uint(ps), __float_as_uint(ps), false, false);
    ps = __uint_as_float(rr[0]) + __uint_as_float(rr[1]); }
  l_reg = l_reg * alpha + ps;
#define PK4(P, BASE, OUT) do { unsigned a0 = cvtpk(P[BASE + 0], P[BASE + 1]), a1 = cvtpk(P[BASE + 2], P[BASE + 3]);   \
    unsigned b0 = cvtpk(P[BASE + 4], P[BASE + 5]), b1 = cvtpk(P[BASE + 6], P[BASE + 7]);                              \
    auto r0 = __builtin_amdgcn_permlane32_swap(a0, b0, false, false); auto r1 = __builtin_amdgcn_permlane32_swap(a1, b1, false, false); \
    u32x4 w = {r0[0], r1[0], r0[1], r1[1]}; OUT = *reinterpret_cast<bf16x8*>(&w); } while (0)
  PK4(p0, 0, pa0); PK4(p0, 8, pa1); PK4(p1, 0, pa2); PK4(p1, 8, pa3);
#undef PK4
}
template <int ND0> __device__ __forceinline__ void qkt(f32x16& p0, f32x16& p1, const char* Ks, const bf16x8* qr, int r32, int hi) {
  p0 = f32x16{}; p1 = f32x16{};
#pragma unroll
  for (int d0 = 0; d0 < ND0; ++d0) { int cb = (d0 * 16 + hi * 8) * 2;
    bf16x8 b0 = *reinterpret_cast<const bf16x8*>(Ks + KSWZ(r32, cb));
    bf16x8 b1 = *reinterpret_cast<const bf16x8*>(Ks + KSWZ(32 + r32, cb));
    p0 = __builtin_amdgcn_mfma_f32_32x32x16_bf16(b0, qr[d0], p0, 0, 0, 0);
    p1 = __builtin_amdgcn_mfma_f32_32x32x16_bf16(b1, qr[d0], p1, 0, 0, 0); }
}
__device__ __forceinline__ int v_st(int k, int c) { const int kk = (k & ~0xC) | ((k & 4) << 1) | ((k & 8) >> 1); return ((kk >> 3) * 4 + (c >> 5)) * 512 + ((kk & 7) * 32 + (c & 31)) * 2; }
__device__ __forceinline__ int v_rd_base(int lane) { return ((lane & 3) << 3) | (((lane >> 2) & 3) << 6) | (((lane >> 4) & 1) << 5) | (((lane >> 5) & 1) << 8); }
constexpr int v_rd_off(int d0, int ks, int half) { return d0 * 512 + ks * 4096 + half * 2048; }
template <int OFF> __device__ __forceinline__ s16x4 tr_read(int vb) {
  s16x4 r; asm volatile("ds_read_b64_tr_b16 %0, %1 offset:%2" : "=&v"(r) : "v"(vb), "i"(OFF) : "memory"); return r;
}
template <int D0> __device__ __forceinline__ void pv_one(f32x16& od, int vb, bf16x8 pa0, bf16x8 pa1, bf16x8 pa2, bf16x8 pa3) {
  const s16x4 l0 = tr_read<v_rd_off(D0, 0, 0)>(vb), h0 = tr_read<v_rd_off(D0, 0, 1)>(vb), l1 = tr_read<v_rd_off(D0, 1, 0)>(vb), h1 = tr_read<v_rd_off(D0, 1, 1)>(vb);
  const s16x4 l2 = tr_read<v_rd_off(D0, 2, 0)>(vb), h2 = tr_read<v_rd_off(D0, 2, 1)>(vb), l3 = tr_read<v_rd_off(D0, 3, 0)>(vb), h3 = tr_read<v_rd_off(D0, 3, 1)>(vb);
  asm volatile("s_waitcnt lgkmcnt(0)" ::: "memory"); SBAR();
#define PK(L, H) (bf16x8){L[0], L[1], L[2], L[3], H[0], H[1], H[2], H[3]}
  od = __builtin_amdgcn_mfma_f32_32x32x16_bf16(pa0, PK(l0, h0), od, 0, 0, 0);
  od = __builtin_amdgcn_mfma_f32_32x32x16_bf16(pa1, PK(l1, h1), od, 0, 0, 0);
  od = __builtin_amdgcn_mfma_f32_32x32x16_bf16(pa2, PK(l2, h2), od, 0, 0, 0);
  od = __builtin_amdgcn_mfma_f32_32x32x16_bf16(pa3, PK(l3, h3), od, 0, 0, 0);
#undef PK
}
__device__ __forceinline__ void pv_d0(f32x16* o, int vb, bf16x8 pa0, bf16x8 pa1, bf16x8 pa2, bf16x8 pa3) {
  pv_one<0>(o[0], vb, pa0, pa1, pa2, pa3); pv_one<1>(o[1], vb, pa0, pa1, pa2, pa3);
}

struct AttnIO {
  const bf16_t* Q1;
  const bf16_t* Q2;
  const bf16_t* K1;
  const bf16_t* K2;
  const bf16_t* V;
  bf16_t* O;
};
template <bool SWA>
__device__ __forceinline__ void attn_unit(const AttnIO io, const int q0  , const float sink, char* lds, int tid_in) {
  constexpr int ND0 = SWA ? 4 : 6;
  constexpr int LDQ1 = 512, LDQ2 = 256, LDK1 = SWA ? 128 : 512, LDK2 = 32, LDV = SWA ? 128 : 512, LDO = 1024;
  constexpr float SCALE = SWA ? 0.125f : 0.10206207261596575f;
  constexpr float C = SCALE * 1.4426950408889634f, THRS = 8.f / SCALE;
  int tid_ = tid_in; asm volatile("" : "+v"(tid_));
  const int tid = tid_, wid = tid >> 6, lane = tid & 63, r32 = lane & 31, hi = lane >> 5;
  char* V_lds = lds + OFF_V; char* K_lds = lds + OFF_K;
  float* ws = (float*)(lds + OFF_WS) + wid * 64; float* li_l = ws; float* al_l = ws + 32;
  float m_reg = -1e30f, l_reg = 0; f32x16 o[2] = {}; bf16x8 qr[ND0];
  {
    const bf16_t* Qw = io.Q1 + (long)(wid * QBLK + r32) * LDQ1 + hi * 8;
#pragma unroll
    for (int d0 = 0; d0 < 4; ++d0) qr[d0] = *reinterpret_cast<const bf16x8*>(Qw + d0 * 16);
    if constexpr (!SWA) {
      const bf16_t* Qw2 = io.Q2 + (long)(wid * QBLK + r32) * LDQ2 + hi * 8;
#pragma unroll
      for (int d0 = 0; d0 < 2; ++d0) qr[4 + d0] = *reinterpret_cast<const bf16x8*>(Qw2 + d0 * 16);
    }
  }
  const int sr = tid >> 3, sc = (tid & 7) * 8, vst = v_st(sr, sc), kst = KSWZ(sr, sc * 2);
  const int sr2 = (tid & 255) >> 2, sc2 = (tid & 3) * 8, kst2 = KSWZ(sr2, (64 + sc2) * 2);
  const int vb0 = (int)(uintptr_t)V_lds + v_rd_base(lane);
  int NT, jlo = 0;
  if constexpr (SWA) { jlo = (q0 == 0) ? 2 : 0; NT = 4 + 8 - jlo - ((q0 == 4096 - 256) ? 2 : 0); } else NT = 68;
#define KEY0(t) (SWA ? ((t) < 4 ? (t) * 64 : 256 + q0 - 128 + ((t) - 4 + jlo) * 64) : (t) * 64)
  struct { bf16x8 v, k, k2; } sr_[2];
#define SLOAD(i, t) do { const long k0_ = KEY0(t); sr_[i].v = *reinterpret_cast<const bf16x8*>(io.V + (k0_ + sr) * LDV + sc); \
    sr_[i].k = *reinterpret_cast<const bf16x8*>(io.K1 + (k0_ + sr) * LDK1 + sc); \
    if constexpr (!SWA) sr_[i].k2 = *reinterpret_cast<const bf16x8*>(io.K2 + (k0_ + sr2) * LDK2 + sc2); } while (0)
#define SWRITE(b, i) do { *(bf16x8*)(V_lds + (b) * SHM_V + vst) = sr_[i].v; *(bf16x8*)(K_lds + (b) * SHM_K + kst) = sr_[i].k; \
    if constexpr (!SWA) { if (tid < 256) *(bf16x8*)(K_lds + (b) * SHM_K + kst2) = sr_[i].k2; } } while (0)
#define SWAIT() do { if constexpr (SWA) asm volatile("s_waitcnt vmcnt(2)" ::: "memory"); else asm volatile("s_waitcnt vmcnt(3)" ::: "memory"); } while (0)
#define RESC(a) do { if (__any((a) < 1.f)) { if (hi == 0) al_l[r32] = (a); asm volatile("s_waitcnt lgkmcnt(0)" ::: "memory"); \
    _Pragma("unroll") for (int d = 0; d < 2; ++d) _Pragma("unroll") for (int r = 0; r < 16; ++r) o[d][r] *= al_l[crow(r, hi)]; } } while (0)
#define MASK(P0, P1, t) do { if constexpr (SWA) { if ((t) >= 4) { const int base_ = -128 + ((t) - 4 + jlo) * 64 - wid * QBLK - r32 + 4 * hi; \
    _Pragma("unroll") for (int r = 0; r < 16; ++r) { const int d_ = base_ + (r & 3) + 8 * (r >> 2); \
      if (d_ > 128 || d_ < -128) P0[r] = -INFINITY; if (d_ + 32 > 128 || d_ + 32 < -128) P1[r] = -INFINITY; } } } } while (0)
  f32x16 pA0, pA1, pB0, pB1; float mnA, mnB, alA, alB; bf16x8 pa0, pa1, pa2, pa3;
  constexpr int SE = 0, SO = 1;
  SLOAD(SE, 0); asm volatile("s_waitcnt vmcnt(0)" ::: "memory"); SWRITE(0, SE); __syncthreads();
  qkt<ND0>(pA0, pA1, K_lds, qr, r32, hi); MASK(pA0, pA1, 0); partialSM(pA0, pA1, m_reg, mnA, alA, C, THRS);
  SLOAD(SO, 1); if (2 < NT) SLOAD(SE, 2);
  SWAIT(); SWRITE(1, SO); __syncthreads();
  for (int j = 1; j + 1 < NT; j += 2) {
    SBAR(); qkt<ND0>(pB0, pB1, K_lds + SHM_K, qr, r32, hi); MASK(pB0, pB1, j);
    finishSM(pA0, pA1, alA, l_reg, pa0, pa1, pa2, pa3); SBAR();
    SLOAD(SO, (j + 2 < NT) ? j + 2 : j); SBAR();
    pv_d0(o, vb0, pa0, pa1, pa2, pa3); partialSM(pB0, pB1, m_reg, mnB, alB, C, THRS);
    __syncthreads(); SWAIT(); SWRITE(0, SE);
    RESC(alB); __syncthreads();
    SBAR(); qkt<ND0>(pA0, pA1, K_lds, qr, r32, hi); MASK(pA0, pA1, j + 1);
    finishSM(pB0, pB1, alB, l_reg, pa0, pa1, pa2, pa3); SBAR();
    if (j + 3 < NT) SLOAD(SE, j + 3); SBAR();
    pv_d0(o, vb0 + SHM_V, pa0, pa1, pa2, pa3); partialSM(pA0, pA1, m_reg, mnA, alA, C, THRS);
    __syncthreads(); SWAIT(); SWRITE(1, SO);
    RESC(alA); __syncthreads();
  }
  SBAR(); qkt<ND0>(pB0, pB1, K_lds + SHM_K, qr, r32, hi); MASK(pB0, pB1, NT - 1);
  finishSM(pA0, pA1, alA, l_reg, pa0, pa1, pa2, pa3); SBAR();
  pv_d0(o, vb0, pa0, pa1, pa2, pa3); partialSM(pB0, pB1, m_reg, mnB, alB, C, THRS);
  __syncthreads(); RESC(alB);
  finishSM(pB0, pB1, alB, l_reg, pa0, pa1, pa2, pa3); SBAR();
  pv_d0(o, vb0 + SHM_V, pa0, pa1, pa2, pa3);
  if constexpr (SWA) l_reg += __builtin_amdgcn_exp2f(sink * 1.4426950408889634f - m_reg * C);
  if (hi == 0) li_l[r32] = l_reg; asm volatile("s_waitcnt lgkmcnt(0)" ::: "memory");
  float rli[16];
#pragma unroll
  for (int r = 0; r < 16; ++r) rli[r] = __builtin_amdgcn_rcpf(li_l[crow(r, hi)]);
  { bf16_t* stg = (bf16_t*)(lds + OFF_OST) + wid * 2048;
#pragma unroll
    for (int r = 0; r < 16; ++r) { const int orow = crow(r, hi);
#pragma unroll
      for (int d0 = 0; d0 < 2; ++d0) stg[orow * 64 + d0 * 32 + r32] = (bf16_t)(cvtpk(o[d0][r] * rli[r], 0.f) & 0xffffu); }
    asm volatile("s_waitcnt lgkmcnt(0)" ::: "memory");
    bf16_t* Ow = io.O + (long)(wid * QBLK) * LDO;
#pragma unroll
    for (int i = 0; i < 4; ++i) { const int row = i * 8 + (lane >> 3), ch = lane & 7; const u32x4 v = *(const u32x4*)(stg + row * 64 + ch * 8); *(u32x4*)(Ow + (long)row * LDO + ch * 8) = v; } }
  __syncthreads();
#undef SLOAD
#undef SWRITE
#undef SWAIT
#undef RESC
#undef MASK
#undef KEY0
}
#undef KSWZ
#undef SBAR
}
constexpr int NWAVES = 8;
constexpr int DM = 1024, NB = 8, SEQ = 4096, CTX = 256, TPB = SEQ + CTX  , RT = NB * TPB  , RL = NB * SEQ  ;
constexpr int DIN = 3232, DINP = 3328, DFF = 2816, DUP = 5632;
constexpr float EPS = 1e-6f;
constexpr size_t MiB = 1u << 20;
constexpr size_t WS_CTL = 0, CTL_ZERO_BYTES = 64 * 1024;
constexpr size_t WS_ROPE_S = 64 * 1024;
constexpr size_t WS_ROPE_M = WS_ROPE_S + 64 * 16 * 8;
constexpr size_t WS_MODF = 128 * 1024;
constexpr size_t WS_SSQ_Q = 512 * 1024;
constexpr size_t WS_SSQ_KV = WS_SSQ_Q + (size_t)RT * 16;
constexpr size_t WS_SSQ_16 = WS_SSQ_KV + (size_t)RT * 16;
constexpr size_t WS_MODP = 4 * MiB;
constexpr size_t WS_WIN = 8 * MiB;
constexpr size_t WS_WQ = WS_WIN + (size_t)DINP * 1024 * 2;
constexpr size_t WS_WKV = WS_WQ + 768 * 256 * 2;
constexpr size_t WS_WOAB = WS_WKV + 1024 * 256 * 2;
constexpr size_t WS_WOUT = WS_WOAB + 1024 * 1024 * 2;
constexpr size_t WS_WUP = WS_WOUT + 1024 * 1024 * 2;
constexpr size_t WS_WDN = WS_WUP + (size_t)DUP * 1024 * 2;
static_assert(WS_WDN + (size_t)1024 * DFF * 2 <= 40 * MiB, "weights");
constexpr size_t WS_H = 40 * MiB;
constexpr size_t WS_G = 108 * MiB;
constexpr size_t WS_QA = 244 * MiB, WS_KVR = 261 * MiB, WS_KR = 278 * MiB, WS_KS = 281 * MiB, WS_VS = 290 * MiB, WS_QS = 299 * MiB;
constexpr size_t WS_QN = 333 * MiB, WS_QR = 367 * MiB, WS_KN = 384 * MiB, WS_VM = 418 * MiB;
constexpr size_t WS_M1 = 452 * MiB;
constexpr size_t WS_END_REQ = 512 * MiB;
constexpr size_t WS_M1b = 244 * MiB;
constexpr size_t WS_AL = 312 * MiB;
constexpr size_t WS_SB = 312 * MiB;
constexpr size_t WS_F = 380 * MiB;
constexpr size_t WS_ACT = 108 * MiB;

constexpr int RING_BYTES = 131072, MISC_OFF = RING_BYTES + 320, LDS_BYTES = 147456;

#define GAS __attribute__((address_space(1)))
#define LAS __attribute__((address_space(3)))
typedef unsigned short bf16;
typedef unsigned v4u __attribute__((ext_vector_type(4)));
typedef unsigned v2u __attribute__((ext_vector_type(2)));
typedef float f32x4 __attribute__((ext_vector_type(4)));
#define LDS_WAIT() asm volatile("s_waitcnt lgkmcnt(0)" ::: "memory")
#define VM_WAIT() asm volatile("s_waitcnt vmcnt(0)" ::: "memory")
__device__ __forceinline__ unsigned pk2(float lo, float hi) { return att::cvtpk(lo, hi); }
__device__ __forceinline__ float bf2f(unsigned short b) { return __uint_as_float((unsigned)b << 16); }
__device__ __forceinline__ v2u pk4(f32x4 v) { v2u w; w.x = pk2(v[0], v[1]); w.y = pk2(v[2], v[3]); return w; }
__device__ __forceinline__ f32x4 unpk4(v2u w) { f32x4 v; v[0] = __uint_as_float(w.x << 16); v[1] = __uint_as_float(w.x & 0xffff0000u); v[2] = __uint_as_float(w.y << 16); v[3] = __uint_as_float(w.y & 0xffff0000u); return v; }

#define XB_TMO      128
#define XB_XCNT(j)  (256  + 64 * (j))
#define XB_XSUB(j)  (1280 + 64 * (j))
#define XB_XGEN(j)  (2304 + 64 * (j))
#define XB_TOP      3328
#define XB_TOPGEN   3392
#define XCD_BAR_WORDS 3456
#define XB_SPIN_CAP (1u << 22)
__device__ __forceinline__ unsigned xb_ld(unsigned* p)              { return __hip_atomic_load(p, __ATOMIC_RELAXED, __HIP_MEMORY_SCOPE_AGENT); }
__device__ __forceinline__ unsigned xb_add(unsigned* p, unsigned v) { return __hip_atomic_fetch_add(p, v, __ATOMIC_RELAXED, __HIP_MEMORY_SCOPE_AGENT); }
__device__ __forceinline__ unsigned xb_xcc_id() { return (unsigned)__builtin_amdgcn_s_getreg((3 << 11) | 20) & 0xFu; }
#define XB_SPIN(cond, bar) do { unsigned _sp = 0; while (cond) { __builtin_amdgcn_s_sleep(1); \
    if ((++_sp & 255u) == 0u) { if (xb_ld(&(bar)[XB_TMO])) break; if (_sp > XB_SPIN_CAP) { atomicAdd(&(bar)[XB_TMO], 1u); break; } } } } while (0)
struct XcdBarrier { unsigned* bar; unsigned x; volatile LAS unsigned* st; };
__device__ __forceinline__ XcdBarrier xcd_barrier_post(unsigned* bar, volatile LAS unsigned* st) {
    XcdBarrier b; b.bar = bar; b.x = xb_xcc_id(); b.st = st;
    if (threadIdx.x == 0) (void)xb_add(&bar[XB_XCNT(b.x)], 1u);
    return b;
}
__device__ __forceinline__ void xcd_barrier_complete(unsigned* bar, unsigned x, unsigned& nloc, unsigned& nx) {
    const unsigned G = gridDim.x * gridDim.y * gridDim.z;
    unsigned sum, cnt, mine, sp = 0u;
    for (;;) {
        sum = 0u; cnt = 0u; mine = 0u;
#pragma unroll
        for (unsigned j = 0; j < 16; ++j) { const unsigned c = xb_ld(&bar[XB_XCNT(j)]); sum += c; cnt += (c > 0u) ? 1u : 0u; mine = (j == x) ? c : mine; }
        if (sum == G) break;
        __builtin_amdgcn_s_sleep(1);
        if ((++sp & 255u) == 0u) { if (xb_ld(&bar[XB_TMO])) break; if (sp > XB_SPIN_CAP) { atomicAdd(&bar[XB_TMO], 1u); break; } }
    }
    nloc = mine > 0u ? mine : 1u; nx = cnt > 0u ? cnt : 1u;
}
__device__ __forceinline__ void xcd_barrier(const XcdBarrier& b) {
    asm volatile("s_waitcnt vmcnt(0)" ::: "memory");
    __syncthreads();
    if (threadIdx.x == 0) {
        unsigned* bar = b.bar;
        __builtin_amdgcn_s_waitcnt(0);
        unsigned nloc = b.st[0], nx = b.st[1];
        if (nloc == 0u) { xcd_barrier_complete(bar, b.x, nloc, nx); b.st[0] = nloc; b.st[1] = nx; }
        const unsigned old = xb_add(&bar[XB_XSUB(b.x)], 1u);
        const unsigned gen = old / nloc;
        if (old + 1u == (gen + 1u) * nloc) {
            __builtin_amdgcn_fence(__ATOMIC_RELEASE, "agent");
            asm volatile("s_waitcnt vmcnt(0)" ::: "memory");
            const unsigned og = xb_add(&bar[XB_TOP], 1u);
            const unsigned tg = og / nx;
            if (og + 1u == (tg + 1u) * nx) xb_add(&bar[XB_TOPGEN], 1u);
            else XB_SPIN(xb_ld(&bar[XB_TOPGEN]) == tg, bar);
            __builtin_amdgcn_fence(__ATOMIC_ACQUIRE, "agent");
            xb_add(&bar[XB_XGEN(b.x)], 1u);
            asm volatile("s_waitcnt vmcnt(0)" ::: "memory");
        } else {
            XB_SPIN(xb_ld(&bar[XB_XGEN(b.x)]) == gen, bar);
            __builtin_amdgcn_fence(__ATOMIC_ACQUIRE, "agent");
            asm volatile("s_waitcnt vmcnt(0)" ::: "memory");
        }
    }
    __syncthreads();
}

__device__ __forceinline__ float wave_sum(float v) {
#pragma unroll
    for (int o = 1; o < 64; o <<= 1) v += __shfl_xor(v, o);
    return v;
}
__device__ __forceinline__ float silu_f(float v) { return v / (1.f + __expf(-v)); }
__device__ __forceinline__ float sigmoid_f(float v) { return 1.f / (1.f + __expf(-v)); }

struct Args { const float* in[24]; float* out; unsigned char* ws; };
enum { I_X = 0, I_C, I_CTX, I_CCTX, I_WADA, I_BADA, I_APRE, I_APOST, I_WIN, I_BGATE, I_QNG, I_WQUP, I_KVNG, I_WKVUP, I_WOM, I_SINK, I_WOS, I_WOUT, I_FPRE, I_FPOST, I_WUP, I_CONVW, I_CONVB, I_WDN };
__device__ __forceinline__ void transpose_item(const float* W, int N, int k0, int n0, bf16* WT, int ldw, int drow0, int dk0, const float* gain, LAS float* scr, int lane) {
#pragma unroll 8
    for (int i = 0; i < 32; ++i) { const int kk = 2 * i + (lane >> 5); float v = W[(size_t)(k0 + kk) * N + n0 + (lane & 31)]; if (gain) v *= gain[k0 + kk]; scr[kk * 33 + (lane & 31)] = v; }
    LDS_WAIT(); asm volatile("" ::: "memory");
    const int c = lane & 7;
#pragma unroll
    for (int j = 0; j < 4; ++j) { const int n = (lane >> 3) + 8 * j; const LAS float* s = scr + (8 * c) * 33 + n;
        v4u o; o.x = pk2(s[0 * 33], s[1 * 33]); o.y = pk2(s[2 * 33], s[3 * 33]); o.z = pk2(s[4 * 33], s[5 * 33]); o.w = pk2(s[6 * 33], s[7 * 33]);
        *(GAS v4u*)(WT + (size_t)(drow0 + n) * ldw + dk0 + k0 + 8 * c) = o; }
    LDS_WAIT(); asm volatile("" ::: "memory");
}
__device__ __forceinline__ int inproj_row(int n) {
    if (n < 416) return n;
    if (n < 928) return n - 416 + 768;
    if (n < 1056) return n - 928 + 512;
    if (n < 1184) return n - 1056 + 640;
    return n - 1184 + 1280;
}
__device__ __forceinline__ float inv_freq16(int f) {
    switch (f) { case 0: return 1.0f; case 1: return 0.5623413324356079f; case 2: return 0.3162277638912201f; case 3: return 0.17782793939113617f; case 4: return 0.10000000149011612f;
        case 5: return 0.05623413249850273f; case 6: return 0.03162277489900589f; case 7: return 0.017782794311642647f; case 8: return 0.009999999776482582f; case 9: return 0.005623413249850273f;
        case 10: return 0.003162277629598975f; case 11: return 0.0017782794311642647f; case 12: return 0.0010000000474974513f; case 13: return 0.000562341301701963f;
        case 14: return 0.0003162277571391314f; default: return 0.00017782794020604342f; }
}
__device__ __forceinline__ void sincos_acc(float ang, float& c, float& s) {
    const double a = (double)ang;
    const double k = __builtin_rint(a * 0.63661977236758134308);
    const double r = (a - k * 1.5707963267948966192) - k * 6.123233995736766e-17;
    const double r2 = r * r;
    const double sn = r * (1.0 + r2 * (-1.0 / 6 + r2 * (1.0 / 120 + r2 * (-1.0 / 5040 + r2 * (1.0 / 362880 + r2 * (-1.0 / 39916800 + r2 * (1.0 / 6227020800.0)))))));
    const double cs = 1.0 + r2 * (-0.5 + r2 * (1.0 / 24 + r2 * (-1.0 / 720 + r2 * (1.0 / 40320 + r2 * (-1.0 / 3628800 + r2 * (1.0 / 479001600.0 + r2 * (-1.0 / 87178291200.0)))))));
    const int q = ((int)k) & 3;
    const double cc = (q == 0) ? cs : (q == 1) ? -sn : (q == 2) ? -cs : sn;
    const double ss = (q == 0) ? sn : (q == 1) ? cs : (q == 2) ? -sn : -cs;
    c = (float)cc; s = (float)ss;
}
__device__ __forceinline__ void p0_prologue(const Args& a, LAS unsigned char* lds, int vcu, int G, int tid, int lane, int wave) {
    unsigned char* ws = a.ws;
    LAS float* scr = (LAS float*)(lds + wave * 16384);
    const int gw = vcu * NWAVES + wave, NGW = G * NWAVES;
    bf16* WIN = (bf16*)(ws + WS_WIN); bf16* WQ = (bf16*)(ws + WS_WQ); bf16* WKV = (bf16*)(ws + WS_WKV); bf16* WOAB = (bf16*)(ws + WS_WOAB);
    bf16* WOUT = (bf16*)(ws + WS_WOUT); bf16* WUP = (bf16*)(ws + WS_WUP); bf16* WDN = (bf16*)(ws + WS_WDN);
    constexpr int I_IN = 16 * (DIN / 32), I_Q = 4 * 24, I_KV = 2 * 32, I_OA = 8 * 32, I_OB = 8 * 32, I_OUT = 16 * 32, I_UP = 16 * (DUP / 32), I_DN = 44 * 32;
    constexpr int NITEMS = I_IN + I_Q + I_KV + I_OA + I_OB + I_OUT + I_UP + I_DN;
    for (int it = gw; it < NITEMS; it += NGW) {
        int r = it;
        if (r < I_IN) { const int nblk = DIN / 32, kb = r / nblk, nb = r % nblk; transpose_item(a.in[I_WIN], DIN, 64 * kb, 32 * nb, WIN, 1024, inproj_row(32 * nb), 0, nullptr, scr, lane); continue; } r -= I_IN;
        if (r < I_Q) { const int kb = r / 24, nb = r % 24, n0 = 32 * nb, hd = n0 / 96, cc = n0 % 96; const int drow = cc < 64 ? hd * 64 + cc : 512 + hd * 32 + (cc - 64);
            transpose_item(a.in[I_WQUP], 768, 64 * kb, n0, WQ, 256, drow, 0, a.in[I_QNG], scr, lane); continue; } r -= I_Q;
        if (r < I_KV) { const int kb = r / 32, nb = r % 32, n0 = 32 * nb, hd = n0 / 128, cc = n0 % 128; const int drow = cc < 64 ? hd * 64 + cc : 512 + hd * 64 + (cc - 64);
            transpose_item(a.in[I_WKVUP], 1024, 64 * kb, n0, WKV, 256, drow, 0, a.in[I_KVNG], scr, lane); continue; } r -= I_KV;
        if (r < I_OA) { const int kb = r / 32, nb = r % 32; transpose_item(a.in[I_WOM], 1024, 64 * kb, 32 * nb, WOAB, 1024, 32 * nb, 0, nullptr, scr, lane); continue; } r -= I_OA;
        if (r < I_OB) { const int kb = r / 32, nb = r % 32; transpose_item(a.in[I_WOS], 1024, 64 * kb, 32 * nb, WOAB, 1024, 32 * nb, 512, nullptr, scr, lane); continue; } r -= I_OB;
        if (r < I_OUT) { const int kb = r / 32, nb = r % 32; transpose_item(a.in[I_WOUT], 1024, 64 * kb, 32 * nb, WOUT, 1024, 32 * nb, 0, nullptr, scr, lane); continue; } r -= I_OUT;
        if (r < I_UP) { const int nblk = DUP / 32, kb = r / nblk, nb = r % nblk, n0 = 32 * nb; const int drow = n0 < DFF ? (n0 / 128) * 256 + (n0 % 128) : ((n0 - DFF) / 128) * 256 + 128 + ((n0 - DFF) % 128);
            transpose_item(a.in[I_WUP], DUP, 64 * kb, n0, WUP, 1024, drow, 0, nullptr, scr, lane); continue; } r -= I_UP;
        { const int kb = r / 32, nb = r % 32; transpose_item(a.in[I_WDN], 1024, 64 * kb, 32 * nb, WDN, DFF, 32 * nb, 0, nullptr, scr, lane); }
    }
    { const int gt = vcu * 512 + tid, NTH = G * 512;
      for (int i = gt; i < 96 * 128; i += NTH) *(GAS v4u*)(WIN + (size_t)(416 + i / 128) * 1024 + (i % 128) * 8) = (v4u){0u, 0u, 0u, 0u};
      for (int i = gt; i < 1024 * 16; i += NTH) *(GAS v4u*)(WKV + (size_t)(i / 16) * 256 + 128 + (i % 16) * 8) = (v4u){0u, 0u, 0u, 0u};
      float2* RS = (float2*)(ws + WS_ROPE_S); float2* RM = (float2*)(ws + WS_ROPE_M);
      for (int i = gt; i < 64 * 16 + 64 * 8; i += NTH) {
          const bool sw = i < 64 * 16; const int j = sw ? i : i - 64 * 16; const int pos = sw ? j / 16 : j / 8, f = sw ? j % 16 : j % 8;
          const int f16 = sw ? f : 2 * f;
          const float inv = inv_freq16(f16);
          const float ang = (float)pos * inv; float c, s; sincos_acc(ang, c, s);
          if (sw) RS[j] = make_float2(c, s); else RM[j] = make_float2(c, s);
      }
    }
    { LAS float* sv = (LAS float*)(lds + wave * 16384 + 12288);
      float* MODP = (float*)(ws + WS_MODP); const float* wada = a.in[I_WADA];
      for (int task = gw; task < 96 * 16; task += NGW) {
          const int cg = task % 96, ks = task / 96, col = cg * 64 + lane, kk0 = ks * 64;
#pragma unroll
          for (int b = 0; b < 9; ++b) { const float cv = (b < 8) ? a.in[I_C][b * 1024 + kk0 + lane] : a.in[I_CCTX][kk0 + lane]; sv[b * 64 + lane] = silu_f(cv); }
          LDS_WAIT(); asm volatile("" ::: "memory");
          float acc[9];
#pragma unroll
          for (int b = 0; b < 9; ++b) acc[b] = 0.f;
#pragma unroll 8
          for (int k = 0; k < 64; ++k) { const float w = wada[(size_t)(kk0 + k) * 6144 + col];
#pragma unroll
              for (int b = 0; b < 9; ++b) acc[b] = fmaf(sv[b * 64 + k], w, acc[b]); }
#pragma unroll
          for (int b = 0; b < 9; ++b) MODP[(size_t)(ks * 9 + b) * 6144 + col] = acc[b];
          LDS_WAIT(); asm volatile("" ::: "memory");
      }
    }
}
__device__ __forceinline__ float mod_from_partials(const float* MODP, const float* bada, int b, int j) {
    float s = bada[j];
#pragma unroll
    for (int ks = 0; ks < 16; ++ks) s += MODP[(size_t)(ks * 9 + b) * 6144 + j];
    return s;
}

__device__ __forceinline__ void p1_norm_mod(const Args& a, LAS unsigned char* lds, int vcu, int G, int tid, int lane, int wave) {
    unsigned char* ws = a.ws; const float* MODP = (const float*)(ws + WS_MODP); float* MODF = (float*)(ws + WS_MODF);
    for (int i = vcu * 512 + tid; i < 9 * 6144; i += G * 512) MODF[i] = mod_from_partials(MODP, a.in[I_BADA], i / 6144, i % 6144);
    LAS float* msh = (LAS float*)lds;
    LAS float* msc = msh + 1024;
    LAS float* mg = msc + 1024;
    bf16* H = (bf16*)(ws + WS_H);
    const int rows_per = (RT + G - 1) / G;
    int r = vcu * rows_per; const int rend = (r + rows_per < RT) ? r + rows_per : RT;
    while (r < rend) {
        const int b = r / TPB, t = r % TPB; const bool ctx = t < CTX; const int seg_end = b * TPB + (ctx ? CTX : TPB); const int e = seg_end < rend ? seg_end : rend;
        const int mb = ctx ? 8 : b;
        __syncthreads();
        for (int j = tid; j < 1024; j += 512) { msh[j] = mod_from_partials(MODP, a.in[I_BADA], mb, j); msc[j] = 1.f + mod_from_partials(MODP, a.in[I_BADA], mb, 1024 + j); mg[j] = a.in[I_APRE][j]; }
        __syncthreads();
        for (int row = r + wave; row < e; row += NWAVES) {
            const int tt = row - b * TPB; const float* src = ctx ? a.in[I_CTX] + (size_t)(b * CTX + tt) * 1024 : a.in[I_X] + (size_t)(b * SEQ + tt - CTX) * 1024;
            const GAS f32x4* xr = (const GAS f32x4*)src + lane;
            f32x4 v[4]; float s = 0.f;
#pragma unroll
            for (int j = 0; j < 4; ++j) { v[j] = xr[64 * j]; s += (v[j].x * v[j].x + v[j].y * v[j].y) + (v[j].z * v[j].z + v[j].w * v[j].w); }
            const float rstd = 1.f / sqrtf(wave_sum(s) * (1.f / 1024.f) + EPS);
            GAS v2u* o8 = (GAS v2u*)(H + (size_t)row * 1024) + lane;
#pragma unroll
            for (int j = 0; j < 4; ++j) { const int c0 = 4 * lane + 256 * j; f32x4 o;
#pragma unroll
                for (int i = 0; i < 4; ++i) o[i] = (v[j][i] * rstd * mg[c0 + i]) * msc[c0 + i] + msh[c0 + i];
                o8[64 * j] = pk4(o); }
        }
        r = e;
    }
    __syncthreads();
}
typedef pg8::f32x4 (AccT)[2][2][4][2];
using pg8::Unit;
__device__ __forceinline__ void st4(bf16* p, f32x4 v) { *(GAS v2u*)p = pk4(v); }
__device__ __forceinline__ float ssq4(f32x4 v) { return (v[0] * v[0] + v[1] * v[1]) + (v[2] * v[2] + v[3] * v[3]); }
__device__ __forceinline__ f32x4 shx32(f32x4 v) { f32x4 r; r[0] = __shfl_xor(v[0], 32); r[1] = __shfl_xor(v[1], 32); r[2] = __shfl_xor(v[2], 32); r[3] = __shfl_xor(v[3], 32); return r; }
__device__ __forceinline__ void rope_pair(f32x4& x0, f32x4& x1, const float2* cs) {
#pragma unroll
    for (int i = 0; i < 4; ++i) { const float c = cs[i].x, s = cs[i].y, a = x0[i], b = x1[i]; x0[i] = a * c - b * s; x1[i] = b * c + a * s; }
}

struct EpiInProj {
    bf16 *QA, *KVR, *KR, *KS, *VS, *QS, *GT; float *SSQ_Q, *SSQ_KV; const float* b_gate; const float2* RS; const float2* RM;
    __device__ __forceinline__ void operator()(const AccT& acc, const Unit& u, int wr, int wc, int fr, int fq) const {
        const int tin = u.pm % 17; const bool ctx = (tin == 0);
        const int row0 = u.pm * 256 + wr * 64 + fr;
        const int pos0 = (tin - 1) * 256 + wr * 64 + fr;
        const int cw = wc * 32 + fq * 4;
        if (u.pn == 0) {
#pragma unroll
            for (int ai = 0; ai < 2; ++ai)
#pragma unroll
                for (int m = 0; m < 4; ++m) { const int row = row0 + ai * 128 + m * 16; float s = 0.f;
#pragma unroll
                    for (int bj = 0; bj < 2; ++bj)
#pragma unroll
                        for (int n = 0; n < 2; ++n) { const f32x4 v = acc[ai][bj][m][n]; s += ssq4(v); st4(QA + (size_t)row * 256 + bj * 128 + cw + n * 16, v); }
                    s += __shfl_xor(s, 16); s += __shfl_xor(s, 32); if (fq == 0) SSQ_Q[(size_t)row * 4 + wc] = s; }
        } else if (u.pn == 1) {
#pragma unroll
            for (int ai = 0; ai < 2; ++ai)
#pragma unroll
                for (int m = 0; m < 4; ++m) { const int row = row0 + ai * 128 + m * 16; float s = 0.f;
#pragma unroll
                    for (int n = 0; n < 2; ++n) { const f32x4 v = acc[ai][0][m][n]; s += ssq4(v); st4(KVR + (size_t)row * 256 + cw + n * 16, v); st4(KVR + (size_t)row * 256 + 128 + cw + n * 16, acc[ai][1][m][n]); }
                    s += __shfl_xor(s, 16); s += __shfl_xor(s, 32); if (fq == 0) SSQ_KV[(size_t)row * 4 + wc] = s;
                    if (wc == 0) {
                        const int pos = pos0 + ai * 128 + m * 16;
#pragma unroll
                        for (int n = 0; n < 2; ++n) { f32x4 v = acc[ai][1][m][n]; const f32x4 p = shx32(v);
                            if (!ctx) { const int pi = (n == 0) ? (pos >> 6) : (pos & 63); const float2* cs = RM + pi * 8 + (fq & 1) * 4;
#pragma unroll
                                for (int i = 0; i < 4; ++i) v[i] = (fq < 2) ? v[i] * cs[i].x - p[i] * cs[i].y : v[i] * cs[i].x + p[i] * cs[i].y; }
                            st4(KR + (size_t)row * 32 + n * 16 + fq * 4, v); }
                    } }
        } else if (u.pn == 2) {
#pragma unroll
            for (int ai = 0; ai < 2; ++ai)
#pragma unroll
                for (int m = 0; m < 4; ++m) { const int row = row0 + ai * 128 + m * 16; const int pos = pos0 + ai * 128 + m * 16;
                    f32x4 x0 = acc[ai][0][m][0], x1 = acc[ai][0][m][1];
                    if (!ctx) { const int pi = (wc & 1) ? (pos & 63) : (pos >> 6); rope_pair(x0, x1, RS + pi * 16 + fq * 4); }
                    st4(KS + (size_t)row * 128 + cw, x0); st4(KS + (size_t)row * 128 + cw + 16, x1);
                    st4(VS + (size_t)row * 128 + cw, acc[ai][1][m][0]); st4(VS + (size_t)row * 128 + cw + 16, acc[ai][1][m][1]); }
        } else if (u.pn <= 4) {
            const int cb = (u.pn - 3) * 256;
#pragma unroll
            for (int ai = 0; ai < 2; ++ai)
#pragma unroll
                for (int m = 0; m < 4; ++m) { const int row = row0 + ai * 128 + m * 16; const int pos = pos0 + ai * 128 + m * 16;
                    const int pi = (wc & 1) ? (pos & 63) : (pos >> 6); const float2* cs = RS + pi * 16 + fq * 4;
#pragma unroll
                    for (int bj = 0; bj < 2; ++bj) { f32x4 x0 = acc[ai][bj][m][0], x1 = acc[ai][bj][m][1]; rope_pair(x0, x1, cs);
                        st4(QS + (size_t)row * 512 + cb + bj * 128 + cw, x0); st4(QS + (size_t)row * 512 + cb + bj * 128 + cw + 16, x1); } }
        } else {
            const int cb = (u.pn - 5) * 256;
            f32x4 bv[2][2];
#pragma unroll
            for (int bj = 0; bj < 2; ++bj)
#pragma unroll
                for (int n = 0; n < 2; ++n) bv[bj][n] = *(const f32x4*)(b_gate + cb + bj * 128 + cw + n * 16);
#pragma unroll
            for (int ai = 0; ai < 2; ++ai)
#pragma unroll
                for (int m = 0; m < 4; ++m) { const int row = row0 + ai * 128 + m * 16;
#pragma unroll
                    for (int bj = 0; bj < 2; ++bj)
#pragma unroll
                        for (int n = 0; n < 2; ++n) { f32x4 v = acc[ai][bj][m][n] + bv[bj][n];
#pragma unroll
                            for (int i = 0; i < 4; ++i) v[i] = sigmoid_f(v[i]);
                            st4(GT + (size_t)row * 2048 + cb + bj * 128 + cw + n * 16, v); } }
        }
    }
};
struct EpiQUp {
    bf16 *QN, *QR; const float* SSQ_Q; const float2* RM;
    __device__ __forceinline__ void operator()(const AccT& acc, const Unit& u, int wr, int wc, int fr, int fq) const {
        const int tin = u.pm % 17; const int row0 = u.pm * 256 + wr * 64 + fr, pos0 = (tin - 1) * 256 + wr * 64 + fr, cw = wc * 32 + fq * 4;
#pragma unroll
        for (int ai = 0; ai < 2; ++ai)
#pragma unroll
            for (int m = 0; m < 4; ++m) { const int row = row0 + ai * 128 + m * 16; const int pos = pos0 + ai * 128 + m * 16;
                asm volatile("" ::: "memory"); __builtin_amdgcn_sched_barrier(0);
                const f32x4 sq = *(const f32x4*)(SSQ_Q + (size_t)row * 4); const float rs = 1.f / sqrtf(((sq[0] + sq[1]) + (sq[2] + sq[3])) * (1.f / 256.f) + EPS);
                if (u.pn < 2) {
#pragma unroll
                    for (int bj = 0; bj < 2; ++bj)
#pragma unroll
                        for (int n = 0; n < 2; ++n) st4(QN + (size_t)row * 512 + u.pn * 256 + bj * 128 + cw + n * 16, acc[ai][bj][m][n] * rs);
                } else {
#pragma unroll
                    for (int bj = 0; bj < 2; ++bj)
#pragma unroll
                        for (int n = 0; n < 2; ++n) { f32x4 v = acc[ai][bj][m][n] * rs; const f32x4 p = shx32(v);
                            const int pi = (n == 0) ? (pos >> 6) : (pos & 63); const float2* cs = RM + pi * 8 + (fq & 1) * 4;
#pragma unroll
                            for (int i = 0; i < 4; ++i) v[i] = (fq < 2) ? v[i] * cs[i].x - p[i] * cs[i].y : v[i] * cs[i].x + p[i] * cs[i].y;
                            st4(QR + (size_t)row * 256 + (bj * 4 + wc) * 32 + n * 16 + fq * 4, v); }
                } }
    }
};
struct EpiKVUp {
    bf16 *KN, *VM; const float* SSQ_KV;
    __device__ __forceinline__ void operator()(const AccT& acc, const Unit& u, int wr, int wc, int fr, int fq) const {
        const int row0 = u.pm * 256 + wr * 64 + fr, cw = wc * 32 + fq * 4;
        bf16* dst = (u.pn < 2) ? KN + u.pn * 256 : VM + (u.pn - 2) * 256;
#pragma unroll
        for (int ai = 0; ai < 2; ++ai)
#pragma unroll
            for (int m = 0; m < 4; ++m) { const int row = row0 + ai * 128 + m * 16;
                asm volatile("" ::: "memory"); __builtin_amdgcn_sched_barrier(0);
                const f32x4 sq = *(const f32x4*)(SSQ_KV + (size_t)row * 4); const float rs = 1.f / sqrtf(((sq[0] + sq[1]) + (sq[2] + sq[3])) * (1.f / 128.f) + EPS);
#pragma unroll
                for (int bj = 0; bj < 2; ++bj)
#pragma unroll
                    for (int n = 0; n < 2; ++n) st4(dst + (size_t)row * 512 + bj * 128 + cw + n * 16, acc[ai][bj][m][n] * rs); }
    }
};
template <bool SECOND> struct EpiMerge {
    bf16* M1; const bf16* GT;
    __device__ __forceinline__ void operator()(const AccT& acc, const Unit& u, int wr, int wc, int fr, int fq) const {
        const int row0 = u.pm * 256 + wr * 64 + fr, c0 = u.pn * 256 + wc * 32 + fq * 4;
#pragma unroll
        for (int ai = 0; ai < 2; ++ai)
#pragma unroll
            for (int m = 0; m < 4; ++m) { const int row = row0 + ai * 128 + m * 16;
#pragma unroll
                for (int bj = 0; bj < 2; ++bj)
#pragma unroll
                    for (int n = 0; n < 2; ++n) { const int col = c0 + bj * 128 + n * 16;
                        const f32x4 g = unpk4(*(const GAS v2u*)(GT + (size_t)row * 2048 + (SECOND ? 1024 : 0) + col)); f32x4 v = g * acc[ai][bj][m][n];
                        if (SECOND) v = v + unpk4(*(const GAS v2u*)(M1 + (size_t)row * 1024 + col));
                        st4(M1 + (size_t)row * 1024 + col, v); } }
    }
};
struct EpiOutSsq {
    bf16* O; float* SSQ;
    __device__ __forceinline__ void operator()(const AccT& acc, const Unit& u, int wr, int wc, int fr, int fq) const {
        const int row0 = u.pm * 256 + wr * 64 + fr, c0 = u.pn * 256 + wc * 32 + fq * 4;
#pragma unroll
        for (int ai = 0; ai < 2; ++ai)
#pragma unroll
            for (int m = 0; m < 4; ++m) { const int row = row0 + ai * 128 + m * 16; float s = 0.f;
#pragma unroll
                for (int bj = 0; bj < 2; ++bj)
#pragma unroll
                    for (int n = 0; n < 2; ++n) { const f32x4 v = acc[ai][bj][m][n]; s += ssq4(v); st4(O + (size_t)row * 1024 + c0 + bj * 128 + n * 16, v); }
                s += __shfl_xor(s, 16); s += __shfl_xor(s, 32); if (fq == 0) SSQ[(size_t)row * 16 + u.pn * 4 + wc] = s; }
    }
};
__device__ __forceinline__ f32x4 bperm4(int addr, f32x4 v) { f32x4 r;
#pragma unroll
    for (int i = 0; i < 4; ++i) r[i] = __int_as_float(__builtin_amdgcn_ds_bpermute(addr, __float_as_int(v[i])));
    return r; }
__device__ __forceinline__ f32x4 sel4(bool c, f32x4 a, f32x4 b) { f32x4 r;
#pragma unroll
    for (int i = 0; i < 4; ++i) r[i] = c ? a[i] : b[i];
    return r; }
struct EpiUp {
    bf16* ACT; float* SB; const float* cw; const float* cb;
    __device__ __forceinline__ void operator()(AccT& acc, const Unit& u, int wr, int wc, int fr, int fq) const {
        const int lane = fq * 16 + fr;
        const int src_prev = ((lane & 48) | ((fr + 15) & 15)) << 2, src_next = ((lane & 48) | ((fr + 1) & 15)) << 2;
        const int bat = u.pm / 17, tin = u.pm % 17;
        const int colw = wc * 32 + fq * 4;
        const bool lo = fr < 2, bnd = lo || fr >= 14; const int which = lo ? fr : fr - 12;
        const bool f0 = (fr == 0), f15 = (fr == 15);
#pragma unroll
        for (int ai = 0; ai < 2; ++ai) {
            const int chunk = (bat * SEQ + (tin - 1) * 256 + ai * 128 + wr * 64) >> 6;
            if (bnd) {
                float* sb = SB + ((size_t)chunk * 4 + which) * DUP + u.pn * 256 + colw;
#pragma unroll
                for (int bj = 0; bj < 2; ++bj)
#pragma unroll
                    for (int n = 0; n < 2; ++n) *(GAS f32x4*)(sb + bj * 128 + n * 16) = lo ? acc[ai][bj][0][n] : acc[ai][bj][3][n];
            }
            const size_t rowb = (size_t)(u.pm * 256 + ai * 128 + wr * 64 + fr);
#pragma unroll
            for (int n = 0; n < 2; ++n) {
#pragma unroll
                for (int bj = 0; bj < 2; ++bj) {
                    asm volatile("" ::: "memory"); __builtin_amdgcn_sched_barrier(0);
                    const int oc = bj * DFF + u.pn * 128 + colw + n * 16;
                    const f32x4 w0 = *(const f32x4*)(cw + oc), w1 = *(const f32x4*)(cw + DUP + oc), w2 = *(const f32x4*)(cw + 2 * DUP + oc), bb = *(const f32x4*)(cb + oc);
                    const f32x4 a0 = acc[ai][bj][0][n], a1 = acc[ai][bj][1][n], a2 = acc[ai][bj][2][n], a3 = acc[ai][bj][3][n];
                    const f32x4 p0 = bperm4(src_prev, a0), p1 = bperm4(src_prev, a1), p2 = bperm4(src_prev, a2), p3 = bperm4(src_prev, a3);
                    const f32x4 n0 = bperm4(src_next, a0), n1 = bperm4(src_next, a1), n2 = bperm4(src_next, a2), n3 = bperm4(src_next, a3);
                    acc[ai][bj][0][n] = bb + w0 * sel4(f0, p3, p0) + w1 * a0 + w2 * sel4(f15, n1, n0);
                    acc[ai][bj][1][n] = bb + w0 * sel4(f0, p0, p1) + w1 * a1 + w2 * sel4(f15, n2, n1);
                    acc[ai][bj][2][n] = bb + w0 * sel4(f0, p1, p2) + w1 * a2 + w2 * sel4(f15, n3, n2);
                    acc[ai][bj][3][n] = bb + w0 * sel4(f0, p2, p3) + w1 * a3 + w2 * sel4(f15, n0, n3);
                }
                asm volatile("" ::: "memory"); __builtin_amdgcn_sched_barrier(0);
#pragma unroll
                for (int m = 0; m < 4; ++m) {
                    const f32x4 gt = acc[ai][0][m][n], vl = acc[ai][1][m][n]; f32x4 o;
#pragma unroll
                    for (int i = 0; i < 4; ++i) o[i] = silu_f(gt[i]) * vl[i];
                    st4(ACT + (rowb + m * 16) * DFF + u.pn * 128 + colw + n * 16, o);
                }
            }
        }
    }
};
__device__ __forceinline__ void p4_attention(const Args& a, char* lds, int vcu, int tid) {
    unsigned char* ws = a.ws;
    const bf16* QN = (const bf16*)(ws + WS_QN); const bf16* QR = (const bf16*)(ws + WS_QR); const bf16* KN = (const bf16*)(ws + WS_KN); const bf16* KR = (const bf16*)(ws + WS_KR); const bf16* VM = (const bf16*)(ws + WS_VM);
    const bf16* QS = (const bf16*)(ws + WS_QS); const bf16* KS = (const bf16*)(ws + WS_KS); const bf16* VS = (const bf16*)(ws + WS_VS); bf16* O2 = (bf16*)(ws + WS_H);
    for (int i = 0; i < 4; ++i) {
        const int unit = i * 256 + vcu; if (unit >= 1024) break;
        const int bh = unit >> 4, qb = unit & 15, b = bh >> 3, h = bh & 7;
        const size_t krow0 = (size_t)b * TPB, qrow0 = krow0 + CTX + qb * 256;
        att::AttnIO io;
        io.Q1 = QN + qrow0 * 512 + h * 64; io.Q2 = QR + qrow0 * 256 + h * 32;
        io.K1 = KN + krow0 * 512 + h * 64; io.K2 = KR + krow0 * 32;
        io.V = VM + krow0 * 512 + h * 64; io.O = O2 + qrow0 * 1024 + h * 64;
        att::attn_unit<false>(io, qb * 256, 0.f, lds, tid);
    }
    for (int i = 0; i < 4; ++i) {
        const int unit = i * 256 + vcu; if (unit >= 1024) break;
        const int bh = unit >> 4, qb = unit & 15, b = bh >> 3, h = bh & 7, kvh = h >> 2;
        const size_t krow0 = (size_t)b * TPB, qrow0 = krow0 + CTX + qb * 256;
        att::AttnIO io;
        io.Q1 = QS + qrow0 * 512 + h * 64; io.Q2 = nullptr;
        io.K1 = KS + krow0 * 128 + kvh * 64; io.K2 = nullptr;
        io.V = VS + krow0 * 128 + kvh * 64; io.O = O2 + qrow0 * 1024 + 512 + h * 64;
        att::attn_unit<true>(io, qb * 256, a.in[I_SINK][h], lds, tid);
    }
}
__device__ __forceinline__ void p7_resid_norm(const Args& a, LAS unsigned char* lds, int vcu, int G, int tid, int lane, int wave) {
    unsigned char* ws = a.ws; const float* MODF = (const float*)(ws + WS_MODF); const bf16* AL = (const bf16*)(ws + WS_AL); const float* SSQ = (const float*)(ws + WS_SSQ_16); bf16* HF = (bf16*)(ws + WS_H);
    LAS float* vpg = (LAS float*)lds; LAS float* vg1 = vpg + 1024; LAS float* vfg = vg1 + 1024; LAS float* vsh = vfg + 1024; LAS float* vsc = vsh + 1024;
    const int rows_per = (RL + G - 1) / G;
    int r = vcu * rows_per; const int rend = (r + rows_per < RL) ? r + rows_per : RL;
    while (r < rend) {
        const int b = r / SEQ; const int seg_end = (b + 1) * SEQ; const int e = seg_end < rend ? seg_end : rend;
        __syncthreads();
        for (int j = tid; j < 1024; j += 512) { vpg[j] = a.in[I_APOST][j]; vg1[j] = MODF[b * 6144 + 2048 + j]; vfg[j] = a.in[I_FPRE][j]; vsh[j] = MODF[b * 6144 + 3072 + j]; vsc[j] = 1.f + MODF[b * 6144 + 4096 + j]; }
        __syncthreads();
        for (int rl = r + wave; rl < e; rl += NWAVES) {
            const size_t row = (size_t)b * TPB + CTX + (rl - b * SEQ);
            const f32x4* sp = (const f32x4*)(SSQ + row * 16); const f32x4 s0 = sp[0], s1 = sp[1], s2 = sp[2], s3 = sp[3];
            const float ssq = ((s0[0] + s0[1]) + (s0[2] + s0[3])) + ((s1[0] + s1[1]) + (s1[2] + s1[3])) + ((s2[0] + s2[1]) + (s2[2] + s2[3])) + ((s3[0] + s3[1]) + (s3[2] + s3[3]));
            const float rstd1 = 1.f / sqrtf(ssq * (1.f / 1024.f) + EPS);
            const GAS f32x4* xr = (const GAS f32x4*)(a.in[I_X] + (size_t)rl * 1024) + lane; GAS f32x4* xo = (GAS f32x4*)(a.out + (size_t)rl * 1024) + lane;
            const GAS v2u* ar = (const GAS v2u*)(AL + row * 1024) + lane;
            f32x4 v[4]; float s = 0.f;
#pragma unroll
            for (int j = 0; j < 4; ++j) { const int c0 = 4 * lane + 256 * j; const f32x4 x = xr[64 * j]; const f32x4 al = unpk4(ar[64 * j]);
#pragma unroll
                for (int i = 0; i < 4; ++i) v[j][i] = x[i] + vg1[c0 + i] * (al[i] * rstd1 * vpg[c0 + i]);
                xo[64 * j] = v[j]; s += ssq4(v[j]); }
            const float rstd2 = 1.f / sqrtf(wave_sum(s) * (1.f / 1024.f) + EPS);
            GAS v2u* o8 = (GAS v2u*)(HF + row * 1024) + lane;
#pragma unroll
            for (int j = 0; j < 4; ++j) { const int c0 = 4 * lane + 256 * j; f32x4 o;
#pragma unroll
                for (int i = 0; i < 4; ++i) o[i] = (v[j][i] * rstd2 * vfg[c0 + i]) * vsc[c0 + i] + vsh[c0 + i];
                o8[64 * j] = pk4(o); }
        }
        r = e;
    }
    __syncthreads();
}
__device__ __forceinline__ void p9_conv_fix(const Args& a, int vcu, int G, int lane, int wave) {
    unsigned char* ws = a.ws; const float* SB = (const float*)(ws + WS_SB); bf16* ACT = (bf16*)(ws + WS_ACT); const float* cw = a.in[I_CONVW]; const float* cb = a.in[I_CONVB];
    const int gw = vcu * NWAVES + wave, NGW = G * NWAVES;
    for (int task = gw; task < 2 * 512; task += NGW) {
        const int chunk = task >> 1, last = task & 1;
        const int t = chunk * 64 + (last ? 63 : 0);
        const int b = t / SEQ, pos = t % SEQ; const size_t row = (size_t)b * TPB + CTX + pos;
        const float* cur = SB + ((size_t)chunk * 4 + (last ? 3 : 0)) * DUP;
        const float* prv = last ? SB + ((size_t)chunk * 4 + 2) * DUP : (pos == 0 ? nullptr : SB + ((size_t)(chunk - 1) * 4 + 3) * DUP);
        const float* nxt = last ? (pos == SEQ - 1 ? nullptr : SB + ((size_t)(chunk + 1) * 4 + 0) * DUP) : SB + ((size_t)chunk * 4 + 1) * DUP;
        for (int cc = lane; cc < DFF; cc += 64) {
            const int pg = (cc >> 7) * 256 + (cc & 127), pv = pg + 128;
            const float gp = prv ? prv[pg] : 0.f, gc = cur[pg], gn = nxt ? nxt[pg] : 0.f, vp = prv ? prv[pv] : 0.f, vc = cur[pv], vn = nxt ? nxt[pv] : 0.f;
            const float ug = cb[cc] + cw[cc] * gp + cw[DUP + cc] * gc + cw[2 * DUP + cc] * gn;
            const float uv = cb[DFF + cc] + cw[DFF + cc] * vp + cw[DUP + DFF + cc] * vc + cw[2 * DUP + DFF + cc] * vn;
            ACT[row * DFF + cc] = (bf16)(pk2(silu_f(ug) * uv, 0.f) & 0xffffu);
        }
    }
}
#ifndef EXP_FFN_SCALE
#define EXP_FFN_SCALE 1.f
#endif
__device__ __forceinline__ void p11_final(const Args& a, LAS unsigned char* lds, int vcu, int G, int tid, int lane, int wave) {
    unsigned char* ws = a.ws; const float* MODF = (const float*)(ws + WS_MODF); const bf16* F = (const bf16*)(ws + WS_F); const float* SSQ = (const float*)(ws + WS_SSQ_16);
    LAS float* vpg = (LAS float*)lds; LAS float* vg2 = vpg + 1024;
    const int rows_per = (RL + G - 1) / G;
    int r = vcu * rows_per; const int rend = (r + rows_per < RL) ? r + rows_per : RL;
    while (r < rend) {
        const int b = r / SEQ; const int seg_end = (b + 1) * SEQ; const int e = seg_end < rend ? seg_end : rend;
        __syncthreads();
        for (int j = tid; j < 1024; j += 512) { vpg[j] = a.in[I_FPOST][j]; vg2[j] = MODF[b * 6144 + 5120 + j]; }
        __syncthreads();
        for (int rl = r + wave; rl < e; rl += NWAVES) {
            const size_t row = (size_t)b * TPB + CTX + (rl - b * SEQ);
            const f32x4* sp = (const f32x4*)(SSQ + row * 16); const f32x4 s0 = sp[0], s1 = sp[1], s2 = sp[2], s3 = sp[3];
            const float ssq = ((s0[0] + s0[1]) + (s0[2] + s0[3])) + ((s1[0] + s1[1]) + (s1[2] + s1[3])) + ((s2[0] + s2[1]) + (s2[2] + s2[3])) + ((s3[0] + s3[1]) + (s3[2] + s3[3]));
            const float rstd = 1.f / sqrtf(ssq * (1.f / 1024.f) + EPS);
            GAS f32x4* xo = (GAS f32x4*)(a.out + (size_t)rl * 1024) + lane; const GAS v2u* fr_ = (const GAS v2u*)(F + row * 1024) + lane;
#pragma unroll
            for (int j = 0; j < 4; ++j) { const int c0 = 4 * lane + 256 * j; f32x4 x = xo[64 * j]; const f32x4 f = unpk4(fr_[64 * j]);
#pragma unroll
                for (int i = 0; i < 4; ++i) x[i] = x[i] + EXP_FFN_SCALE * vg2[c0 + i] * (f[i] * rstd * vpg[c0 + i]);
                xo[64 * j] = x; }
        }
        r = e;
    }
}

__device__ __forceinline__ int lane_id_volatile() { int l; asm volatile("v_mbcnt_lo_u32_b32 %0, -1, 0\n\tv_mbcnt_hi_u32_b32 %0, -1, %0" : "=v"(l)); return l; }

#ifdef DEBUG_FFN
constexpr int DBG_W = 8192;
__device__ __forceinline__ unsigned dbg_hash(unsigned x) { x ^= x >> 16; x *= 0x7feb352du; x ^= x >> 15; x *= 0x846ca68bu; x ^= x >> 16; return x; }
__device__ __forceinline__ void dbg_check_act(const Args& a, int vcu, int G, int lane, int wave) {
    unsigned char* ws = a.ws; const bf16* HF = (const bf16*)(ws + WS_H); const bf16* ACT = (const bf16*)(ws + WS_ACT); unsigned* ctl = (unsigned*)(ws + WS_CTL);
    const float* wup = a.in[I_WUP]; const float* cw = a.in[I_CONVW]; const float* cb = a.in[I_CONVB];
    const int s = vcu * NWAVES + wave;
    const unsigned h1 = dbg_hash(s * 3 + 1), h2 = dbg_hash(s * 3 + 2), h3 = dbg_hash(s * 3 + 3);
    const int type = s % 5, chunk = h1 % 512;
    int ric = 0;
    if (type == 0) ric = 16 * (h2 % 4) + 1 + (h3 % 14); else if (type == 1) ric = 16 * (1 + h2 % 3); else if (type == 2) ric = 16 * (h2 % 3) + 15; else if (type == 3) ric = 0; else ric = 63;
    const int t = chunk * 64 + ric, b = t / SEQ, pos = t % SEQ, cc = (h3 >> 8) % DFF;
    float ug = cb[cc], uv = cb[DFF + cc];
    for (int j = 0; j < 3; ++j) {
        const int pp = pos + j - 1; if (pp < 0 || pp >= SEQ) continue;
        const bf16* hr = HF + ((size_t)b * TPB + CTX + pp) * 1024;
        float sg = 0.f, sv = 0.f;
        for (int k = lane; k < 1024; k += 64) { const float hv = bf2f(hr[k]); sg += hv * wup[(size_t)k * DUP + cc]; sv += hv * wup[(size_t)k * DUP + DFF + cc]; }
        sg = wave_sum(sg); sv = wave_sum(sv);
        ug += cw[j * DUP + cc] * sg; uv += cw[j * DUP + DFF + cc] * sv;
    }
    const float ref = silu_f(ug) * uv; const float got = bf2f(ACT[((size_t)b * TPB + CTX + pos) * DFF + cc]);
    const float d = fabsf(ref - got);
    if (lane == 0) { if (d > 0.03f + 0.03f * fabsf(ref)) atomicOr(ctl + DBG_W, 1u << type); atomicMax(ctl + DBG_W + 1, (unsigned)(d * 1000.f)); }
}
#endif
__global__ void __launch_bounds__(NWAVES * 64, 2) fwd_kernel(Args args) {
    extern __shared__ __attribute__((aligned(16))) unsigned char lds_raw[];
    LAS unsigned char* lds = (LAS unsigned char*)lds_raw;
    volatile LAS unsigned* MISC = (volatile LAS unsigned*)(lds + MISC_OFF);
    const int tid0 = threadIdx.x; const int wave0 = __builtin_amdgcn_readfirstlane(tid0 >> 6);
#define TID() (wave0 * 64 + lane_id_volatile())
    const int G = gridDim.x; const int bx = blockIdx.x; const int vcu = (G % 8 == 0) ? (bx % 8) * (G / 8) + bx / 8 : bx;
    unsigned char* ws = args.ws;
    for (int u = tid0; u < (LDS_BYTES - RING_BYTES) / 4; u += NWAVES * 64) ((LAS unsigned*)(lds + RING_BYTES))[u] = 0u;
    __syncthreads();
    XcdBarrier bar = xcd_barrier_post((unsigned*)(ws + WS_CTL), MISC + 8);
#define GRID_BAR() xcd_barrier(bar)
    bf16* H = (bf16*)(ws + WS_H);
#define PH(n) (!defined(ONLY) || ONLY == (n))
    asm volatile("; PHASE_MARK 0");
#if !defined(ONLY) || ONLY == 0
    { int tid = TID(); asm volatile("" : "+v"(tid)); const int lane = tid & 63, wave = __builtin_amdgcn_readfirstlane(tid >> 6); p0_prologue(args, lds, vcu, G, tid, lane, wave); }
#endif
    GRID_BAR();
    asm volatile("; PHASE_MARK 1");
#if !defined(ONLY) || ONLY == 1
    { int tid = TID(); asm volatile("" : "+v"(tid)); const int lane = tid & 63, wave = __builtin_amdgcn_readfirstlane(tid >> 6); p1_norm_mod(args, lds, vcu, G, tid, lane, wave); }
#endif
    GRID_BAR();
    asm volatile("; PHASE_MARK 2");
#if !defined(ONLY) || ONLY == 2
    {
        pg8::Gemm g{H, (const bf16*)(ws + WS_WIN), 1024, 1024, 1024}; pg8::Order<2> S{13, G, bx};
        EpiInProj E{(bf16*)(ws + WS_QA), (bf16*)(ws + WS_KVR), (bf16*)(ws + WS_KR), (bf16*)(ws + WS_KS), (bf16*)(ws + WS_VS), (bf16*)(ws + WS_QS), (bf16*)(ws + WS_G),
                    (float*)(ws + WS_SSQ_Q), (float*)(ws + WS_SSQ_KV), args.in[I_BGATE], (const float2*)(ws + WS_ROPE_S), (const float2*)(ws + WS_ROPE_M)};
        pg8::gemm_phase(lds, g, S, E, TID());
    }
#endif
    GRID_BAR();
    asm volatile("; PHASE_MARK 3");
#if (!defined(ONLY) || ONLY == 3) && !defined(NO3A)
    {
        pg8::Gemm g{(const bf16*)(ws + WS_QA), (const bf16*)(ws + WS_WQ), 256, 256, 256}; pg8::Order<1> S{3, G, bx};
        EpiQUp E{(bf16*)(ws + WS_QN), (bf16*)(ws + WS_QR), (const float*)(ws + WS_SSQ_Q), (const float2*)(ws + WS_ROPE_M)};
        pg8::gemm_phase(lds, g, S, E, TID());
    }
#endif
#if (!defined(ONLY) || ONLY == 3) && !defined(NO3B)
    {
        pg8::Gemm g{(const bf16*)(ws + WS_KVR), (const bf16*)(ws + WS_WKV), 256, 256, 256}; pg8::Order<0> S{4, G, bx};
        EpiKVUp E{(bf16*)(ws + WS_KN), (bf16*)(ws + WS_VM), (const float*)(ws + WS_SSQ_KV)};
        pg8::gemm_phase(lds, g, S, E, TID());
    }
#endif
    GRID_BAR();
    asm volatile("; PHASE_MARK 4");
#if !defined(ONLY) || ONLY == 4
    p4_attention(args, (char*)lds_raw, vcu, TID());
#endif
    GRID_BAR();
    asm volatile("; PHASE_MARK 5");
#if !defined(ONLY) || ONLY == 5
    {
        pg8::Gemm g{H, (const bf16*)(ws + WS_WOAB), 1024, 1024, 512}; pg8::Order<1> S{4, G, bx};
        EpiMerge<false> E{(bf16*)(ws + WS_M1b), (const bf16*)(ws + WS_G)};
        pg8::gemm_phase(lds, g, S, E, TID());
    }
    {
        pg8::Gemm g{H + 512, (const bf16*)(ws + WS_WOAB) + 512, 1024, 1024, 512}; pg8::Order<1> S{4, G, bx};
        EpiMerge<true> E{(bf16*)(ws + WS_M1b), (const bf16*)(ws + WS_G)};
        pg8::gemm_phase(lds, g, S, E, TID());
    }
#endif
    GRID_BAR();
    asm volatile("; PHASE_MARK 6");
#if !defined(ONLY) || ONLY == 6
    {
        pg8::Gemm g{(const bf16*)(ws + WS_M1b), (const bf16*)(ws + WS_WOUT), 1024, 1024, 1024}; pg8::Order<1> S{4, G, bx};
        EpiOutSsq E{(bf16*)(ws + WS_AL), (float*)(ws + WS_SSQ_16)};
        pg8::gemm_phase(lds, g, S, E, TID());
    }
#endif
    GRID_BAR();
    asm volatile("; PHASE_MARK 7");
#if !defined(ONLY) || ONLY == 7
    { int tid = TID(); asm volatile("" : "+v"(tid)); const int lane = tid & 63, wave = __builtin_amdgcn_readfirstlane(tid >> 6); p7_resid_norm(args, lds, vcu, G, tid, lane, wave); }
#endif
    GRID_BAR();
    asm volatile("; PHASE_MARK 8");
#if !defined(ONLY) || ONLY == 8
    {
        pg8::Gemm g{H, (const bf16*)(ws + WS_WUP), 1024, 1024, 1024}; pg8::Order<1> S{22, G, bx};
        EpiUp E{(bf16*)(ws + WS_ACT), (float*)(ws + WS_SB), args.in[I_CONVW], args.in[I_CONVB]};
        pg8::gemm_phase(lds, g, S, E, TID());
    }
#endif
    GRID_BAR();
    asm volatile("; PHASE_MARK 9");
#if !defined(ONLY) || ONLY == 9
    { int tid = TID(); asm volatile("" : "+v"(tid)); const int lane = tid & 63, wave = __builtin_amdgcn_readfirstlane(tid >> 6); p9_conv_fix(args, vcu, G, lane, wave); }
#endif
    GRID_BAR();
    asm volatile("; PHASE_MARK 10");
#if !defined(ONLY) || ONLY == 10
    {
        pg8::Gemm g{(const bf16*)(ws + WS_ACT), (const bf16*)(ws + WS_WDN), DFF, DFF, DFF}; pg8::Order<1> S{4, G, bx};
        EpiOutSsq E{(bf16*)(ws + WS_F), (float*)(ws + WS_SSQ_16)};
        pg8::gemm_phase(lds, g, S, E, TID());
    }
#endif
    GRID_BAR();
    asm volatile("; PHASE_MARK 11");
#ifdef DEBUG_FFN
    { int tid = TID(); asm volatile("" : "+v"(tid)); const int lane = tid & 63, wave = __builtin_amdgcn_readfirstlane(tid >> 6); dbg_check_act(args, vcu, G, lane, wave); }
    GRID_BAR();
#endif
#if !defined(ONLY) || ONLY == 11
    { int tid = TID(); asm volatile("" : "+v"(tid)); const int lane = tid & 63, wave = __builtin_amdgcn_readfirstlane(tid >> 6); p11_final(args, lds, vcu, G, tid, lane, wave); }
#endif
#ifdef DEBUG_FFN
    if (bx == 0 && TID() == 0) { unsigned* ctl = (unsigned*)(ws + WS_CTL); const unsigned mask = __hip_atomic_load(ctl + DBG_W, __ATOMIC_RELAXED, __HIP_MEMORY_SCOPE_AGENT), md = __hip_atomic_load(ctl + DBG_W + 1, __ATOMIC_RELAXED, __HIP_MEMORY_SCOPE_AGENT);
        float mant = 10.f + fminf(89.f, (float)md * 0.01f); float v = mant; for (unsigned i = 0; i < 4 + mask; ++i) v *= 10.f; args.out[0] = v; }
#endif
}

extern "C" void kernel_launch(void* const* d_in, const int* in_sizes, int n_in, void* d_out, int out_size, void* d_ws, size_t ws_size, hipStream_t stream) {
    static int grid = 0;
    if (grid == 0) {
        if (n_in != 24 || out_size != RL * DM || ws_size < 452 * MiB) { fprintf(stderr, "kernel_launch: unexpected shapes (n_in %d out %d ws %zu)\n", n_in, out_size, ws_size); grid = -1; return; }
        int dev = 0, cus = 0;
        if (hipGetDevice(&dev) != hipSuccess || hipDeviceGetAttribute(&cus, hipDeviceAttributeMultiprocessorCount, dev) != hipSuccess) { grid = -1; return; }
        if (hipFuncSetAttribute((const void*)fwd_kernel, hipFuncAttributeMaxDynamicSharedMemorySize, LDS_BYTES) != hipSuccess) { fprintf(stderr, "kernel_launch: hipFuncSetAttribute failed\n"); grid = -1; return; }
        int per_cu = 0;
        if (hipOccupancyMaxActiveBlocksPerMultiprocessor(&per_cu, (const void*)fwd_kernel, NWAVES * 64, LDS_BYTES) != hipSuccess || per_cu < 1) fprintf(stderr, "kernel_launch: occupancy query says %d\n", per_cu);
        (void)hipGetLastError();
        grid = cus;
    }
    if (grid < 0) return;
    if (hipMemsetAsync((char*)d_ws + WS_CTL, 0, CTL_ZERO_BYTES, stream) != hipSuccess) return;
    Args a{};
    for (int i = 0; i < 24; ++i) a.in[i] = (const float*)d_in[i];
    a.out = (float*)d_out; a.ws = (unsigned char*)d_ws;
    hipLaunchKernelGGL(fwd_kernel, dim3(grid), dim3(NWAVES * 64), LDS_BYTES, stream, a);
}
```

```cpp
#include <hip/hip_runtime.h>
#include <hip/hip_bf16.h>
#include <cstdio>
#include <cstdint>
#include <cmath>
namespace pg8 {
#define PG8_LAS __attribute__((address_space(3)))
typedef unsigned short bf16_t;
typedef short bf16x8 __attribute__((ext_vector_type(8)));
typedef float f32x4 __attribute__((ext_vector_type(4)));
typedef unsigned u32x4 __attribute__((ext_vector_type(4)));
typedef unsigned u32x2 __attribute__((ext_vector_type(2)));
constexpr int BM = 256, BK = 64, HALF = 128, HTB = HALF * BK * 2, STAGE_BYTES = 8 * HTB, NXCD = 8, WGM = 8;

__host__ __device__ __forceinline__ int lds_byte(int r, int c) { const int st = (r >> 4) * 2 + (c >> 5), rr = r & 15, cc = c & 31, ob = rr * 64 + cc * 2; return st * 1024 + (ob ^ (((ob >> 9) & 1) << 5)); }
__host__ __device__ __forceinline__ void stage_rc(int b, int& R, int& C) { const int st = b / 1024, sb = b % 1024, swz = sb ^ (((sb >> 9) & 1) << 5); R = (st >> 1) * 16 + swz / 64; C = (st & 1) * 32 + (swz % 64) / 2; }

struct Unit { int pm, pn; };
struct Gemm { const bf16_t* A; const bf16_t* Bt; int lda, ldb, K; };

__device__ __forceinline__ bool static_unit(int nM, int nN, long L, Unit& u) {
    const int nwg = nM * nN; if (L >= nwg) return false;
    int wgid = (int)L; { const int q = nwg / NXCD, r = nwg % NXCD, xcd = wgid % NXCD, off = wgid / NXCD; wgid = (xcd < r ? xcd * (q + 1) : r * (q + 1) + (xcd - r) * q) + off; }
    const int nig = WGM * nN, gid = wgid / nig, fm = gid * WGM, gsz = (nM - fm) < WGM ? (nM - fm) : WGM;
    u.pm = fm + ((wgid % nig) % gsz); u.pn = (wgid % nig) / gsz; return true;
}
template <int MODE> struct Order {
    int nN, G, c;
    __device__ __forceinline__ bool next(int i, Unit& u) const {
        const long L = (long)i * G + c;
        if (MODE == 0) return static_unit(136, nN, L, u);
        if (MODE == 1) { if (!static_unit(128, nN, L, u)) return false; u.pm = (u.pm >> 4) * 17 + 1 + (u.pm & 15); return true; }
        if (static_unit(128, 13, L, u)) { u.pm = (u.pm >> 4) * 17 + 1 + (u.pm & 15); return true; }
        const long e = L - 128 * 13; if (e >= 16) return false;
        u.pm = (int)(e >> 1) * 17; u.pn = 1 + (int)(e & 1); return true;
    }
};

template <class Epi, class Sched>
__device__ __forceinline__ void gemm_phase(PG8_LAS unsigned char* lds, const Gemm g, const Sched& S, const Epi& E, int tid_in) {
    int tid_ = tid_in; asm volatile("" : "+v"(tid_));
    const int tid = tid_, wid = __builtin_amdgcn_readfirstlane(tid >> 6), lane = tid & 63, wr = wid >> 2, wc = wid & 3, fr = lane & 15, fq = lane >> 4;
    const int K = g.K, nt = K / BK;
    unsigned voffA[2], voffB[2];
#pragma unroll
    for (int i = 0; i < 2; ++i) { int R, C; stage_rc(tid * 16 + i * 8192, R, C);
        voffA[i] = (unsigned)(R * g.lda + C) * 2u; voffB[i] = (unsigned)(R * g.ldb + C) * 2u; }
    const size_t kstep = (size_t)(BK * 2);
    const size_t hstepA = (size_t)HALF * g.lda * 2, hstepB = (size_t)HALF * g.ldb * 2;
    const size_t tstepA = 2 * hstepA, tstepB = 2 * hstepB;
    const unsigned ldsw = (unsigned)wid * 1024u;
    const int aoff = lds_byte(wr * 64 + fr, fq * 8), boff = lds_byte(wc * 32 + fr, fq * 8);
#define PG8_SA(b, h) (((b) * 2 + (h)) * HTB)
#define PG8_SB(b, h) ((4 + (b) * 2 + (h)) * HTB)
#define PG8_STAGE(bufoff, gbase, voff) do { _Pragma("unroll") for (int _i = 0; _i < 2; ++_i) \
        __builtin_amdgcn_global_load_lds((const unsigned*)((const char*)(gbase) + (voff)[_i]), (PG8_LAS unsigned*)(lds + (bufoff) + ldsw + _i * 8192), 16, 0, 0); } while (0)
#define PG8_LDA(dst, b, h) do { _Pragma("unroll") for (int m = 0; m < 4; ++m) _Pragma("unroll") for (int k = 0; k < 2; ++k) dst[m][k] = *(const PG8_LAS bf16x8*)(lds + PG8_SA(b, h) + aoff + m * 2048 + k * 1024); } while (0)
#define PG8_LDB(dst, b, h) do { _Pragma("unroll") for (int n = 0; n < 2; ++n) _Pragma("unroll") for (int k = 0; k < 2; ++k) dst[n][k] = *(const PG8_LAS bf16x8*)(lds + PG8_SB(b, h) + boff + n * 2048 + k * 1024); } while (0)
#define PG8_MMA(ai, bj, At, Bt) do { __builtin_amdgcn_s_setprio(1); _Pragma("unroll") for (int m = 0; m < 4; ++m) _Pragma("unroll") for (int n = 0; n < 2; ++n) _Pragma("unroll") for (int k = 0; k < 2; ++k) \
        acc[ai][bj][m][n] = __builtin_amdgcn_mfma_f32_16x16x32_bf16(Bt[n][k], At[m][k], acc[ai][bj][m][n], 0, 0, 0); __builtin_amdgcn_s_setprio(0); } while (0)
#define PG8_WAIT_V(n) asm volatile("s_waitcnt vmcnt(" #n ")" ::: "memory")
#define PG8_WAIT_L(n) asm volatile("s_waitcnt lgkmcnt(" #n ")" ::: "memory")
#define PG8_BAR __builtin_amdgcn_s_barrier()
#define PG8_SCHED __builtin_amdgcn_sched_barrier(0)
    Unit cur, nxt; int ui = 0;
    if (!S.next(0, cur)) return;
    f32x4 acc[2][2][4][2];
#pragma unroll
    for (int a = 0; a < 2; ++a)
#pragma unroll
        for (int b = 0; b < 2; ++b)
#pragma unroll
            for (int m = 0; m < 4; ++m)
#pragma unroll
                for (int n = 0; n < 2; ++n) acc[a][b][m][n] = (f32x4){0.f, 0.f, 0.f, 0.f};
    bf16x8 At[4][2], B0[2][2], B1[2][2];
    const char* cA = (const char*)g.A + (size_t)cur.pm * tstepA; const char* cB = (const char*)g.Bt + (size_t)cur.pn * tstepB;
    PG8_STAGE(PG8_SB(0, 0), cB, voffB); PG8_STAGE(PG8_SB(0, 1), cB + hstepB, voffB); PG8_STAGE(PG8_SA(0, 0), cA, voffA); PG8_STAGE(PG8_SA(0, 1), cA + hstepA, voffA);
    if (wr == 1) PG8_BAR;
    PG8_WAIT_V(2); PG8_BAR;
    PG8_STAGE(PG8_SB(1, 0), cB + kstep, voffB); PG8_STAGE(PG8_SA(1, 0), cA + kstep, voffA); PG8_STAGE(PG8_SB(1, 1), cB + hstepB + kstep, voffB);
    PG8_WAIT_V(6); PG8_BAR;
    for (;;) {
        const bool has_next = S.next(ui + 1, nxt);
        const char* nA = has_next ? (const char*)g.A + (size_t)nxt.pm * tstepA : cA; const char* nB = has_next ? (const char*)g.Bt + (size_t)nxt.pn * tstepB : cB;
        for (int t = 0; t < nt; t += 2) {
            if constexpr (Epi::MID_T > 0) { if (t == Epi::MID_T) { int fr_ = fr, fq_ = fq; asm volatile("" : "+v"(fr_), "+v"(fq_)); E.mid(acc, cur, wr, wc, fr_, fq_); } }
            const bool last = (t == nt - 2);
            const char* a1 = cA + (size_t)(t + 1) * kstep;
            const char* a2 = last ? nA : cA + (size_t)(t + 2) * kstep; const char* b2 = last ? nB : cB + (size_t)(t + 2) * kstep;
            const char* a3 = a2 + kstep; const char* b3 = b2 + kstep;
            PG8_LDB(B0, 0, 0); PG8_LDB(B1, 0, 1); PG8_SCHED; PG8_LDA(At, 0, 0); PG8_STAGE(PG8_SA(1, 1), a1 + hstepA, voffA);
            PG8_WAIT_V(8); PG8_WAIT_L(0); PG8_BAR; PG8_MMA(0, 0, At, B0); PG8_MMA(0, 1, At, B1); PG8_BAR; PG8_SCHED;
            PG8_LDA(At, 0, 1); PG8_STAGE(PG8_SB(0, 0), b2, voffB); PG8_STAGE(PG8_SB(0, 1), b2 + hstepB, voffB); PG8_STAGE(PG8_SA(0, 0), a2, voffA);
            PG8_WAIT_V(8); PG8_WAIT_L(0); PG8_BAR; PG8_MMA(1, 0, At, B0); PG8_MMA(1, 1, At, B1); PG8_BAR; PG8_SCHED;
            PG8_LDB(B0, 1, 0); PG8_LDB(B1, 1, 1); PG8_SCHED; PG8_LDA(At, 1, 0); PG8_STAGE(PG8_SA(0, 1), a2 + hstepA, voffA);
            PG8_WAIT_V(8); PG8_WAIT_L(0); PG8_BAR; PG8_MMA(0, 0, At, B0); PG8_MMA(0, 1, At, B1); PG8_BAR; PG8_SCHED;
            PG8_LDA(At, 1, 1); PG8_STAGE(PG8_SB(1, 0), b3, voffB); PG8_STAGE(PG8_SB(1, 1), b3 + hstepB, voffB); PG8_STAGE(PG8_SA(1, 0), a3, voffA);
            PG8_WAIT_V(8); PG8_WAIT_L(0); PG8_BAR; PG8_MMA(1, 0, At, B0); PG8_MMA(1, 1, At, B1); PG8_BAR; PG8_SCHED;
        }
        if (wr == 0) PG8_BAR;
        { int fr_ = fr, fq_ = fq; asm volatile("" : "+v"(fr_), "+v"(fq_));
          E(acc, cur, wr, wc, fr_, fq_); }
        if (!has_next) break;
#pragma unroll
        for (int a = 0; a < 2; ++a)
#pragma unroll
            for (int b = 0; b < 2; ++b)
#pragma unroll
                for (int m = 0; m < 4; ++m)
#pragma unroll
                    for (int n = 0; n < 2; ++n) acc[a][b][m][n] = (f32x4){0.f, 0.f, 0.f, 0.f};
        cur = nxt; cA = nA; cB = nB; ++ui;
        if (wr == 1) PG8_BAR;
    }
    PG8_WAIT_V(0);
    PG8_BAR;
#undef PG8_SA
#undef PG8_SB
#undef PG8_STAGE
#undef PG8_LDA
#undef PG8_LDB
#undef PG8_MMA
#undef PG8_WAIT_V
#undef PG8_WAIT_L
#undef PG8_BAR
#undef PG8_SCHED
}
}
namespace att {
typedef unsigned short bf16_t;
using bf16x8 = __attribute__((ext_vector_type(8))) short;
using s16x4  = __attribute__((ext_vector_type(4))) short;
using f32x16 = __attribute__((ext_vector_type(16))) float;
using u32x4  = __attribute__((ext_vector_type(4))) unsigned;
constexpr int NW = 8, QBLK = 32, KVBLK = 64;
constexpr int SHM_V = 64 * 64 * 2, SHM_K = 64 * 128 * 2, NVB = 4, NKB = 3;
constexpr int OFF_V = 0, OFF_K = NVB * SHM_V, OFF_WS = OFF_K + NKB * SHM_K, OFF_OST = OFF_WS + NW * 64 * 4, ATT_LDS = OFF_OST + NW * 4096;
#define KSWZ(row, colB) ((row) * 256 + ((colB) ^ (((row) & 7) << 4)))
#define SBAR() __builtin_amdgcn_sched_barrier(0)
__device__ __forceinline__ int crow(int r, int hi) { return (r & 3) + 8 * (r >> 2) + 4 * hi; }
typedef float f32x2_t __attribute__((ext_vector_type(2))); typedef __bf16 bf16x2_t __attribute__((ext_vector_type(2)));
__device__ __forceinline__ unsigned cvtpk(float lo, float hi) { f32x2_t v = {lo, hi}; bf16x2_t b = __builtin_convertvector(v, bf16x2_t); return __builtin_bit_cast(unsigned, b); }

template <int SC1000000  > struct Dummy {};

template <int VAR> __device__ __forceinline__ void partialSM(f32x16& p0, f32x16& p1, float& m_reg, float& mn, float& alpha, const float C, const float THRS) {
  float pmax = p0[0];
#pragma unroll
  for (int r = 1; r < 16; ++r) pmax = fmaxf(pmax, p0[r]);
#pragma unroll
  for (int r = 0; r < 16; ++r) pmax = fmaxf(pmax, p1[r]);
  { auto rr = __builtin_amdgcn_permlane32_swap(__float_as_uint(pmax), __float_as_uint(pmax), false, false);
    pmax = fmaxf(__uint_as_float(rr[0]), __uint_as_float(rr[1])); }
  if (__builtin_expect(__all(pmax - m_reg <= THRS), 1)) { mn = m_reg; alpha = 1.f; }
  else { mn = fmaxf(m_reg, pmax); alpha = __builtin_amdgcn_exp2f((m_reg - mn) * C); m_reg = mn; }
  float mnC = -mn * C;
#pragma unroll
  for (int r = 0; r < 16; ++r) p0[r] = fmaf(p0[r], C, mnC);
#pragma unroll
  for (int r = 0; r < 16; ++r) p1[r] = fmaf(p1[r], C, mnC);
#pragma unroll
  for (int r = 0; r < 16; ++r) p0[r] = (VAR & 1) ? p0[r] * 0.001f : __builtin_amdgcn_exp2f(p0[r]);
}
template <int VAR> __device__ __forceinline__ void finishSM(f32x16& p0, f32x16& p1, float alpha, float& l_reg, bf16x8& pa0, bf16x8& pa1, bf16x8& pa2, bf16x8& pa3) {
#pragma unroll
  for (int r = 0; r < 16; ++r) p1[r] = (VAR & 1) ? p1[r] * 0.001f : __builtin_amdgcn_exp2f(p1[r]);
  float ps = 0;
#pragma unroll
  for (int r = 0; r < 16; ++r) ps += p0[r];
#pragma unroll
  for (int r = 0; r < 16; ++r) ps += p1[r];
  { auto rr = __builtin_amdgcn_permlane32_swap(__float_as_uint(ps), __float_as_uint(ps), false, false);
    ps = __uint_as_float(rr[0]) + __uint_as_float(rr[1]); }
  l_reg = l_reg * alpha + ps;
#define PK4(P, BASE, OUT) do { unsigned a0 = cvtpk(P[BASE + 0], P[BASE + 1]), a1 = cvtpk(P[BASE + 2], P[BASE + 3]);   \
    unsigned b0 = cvtpk(P[BASE + 4], P[BASE + 5]), b1 = cvtpk(P[BASE + 6], P[BASE + 7]);                              \
    auto r0 = __builtin_amdgcn_permlane32_swap(a0, b0, false, false); auto r1 = __builtin_amdgcn_permlane32_swap(a1, b1, false, false); \
    u32x4 w = {r0[0], r1[0], r0[1], r1[1]}; OUT = *reinterpret_cast<bf16x8*>(&w); } while (0)
  PK4(p0, 0, pa0); PK4(p0, 8, pa1); PK4(p1, 0, pa2); PK4(p1, 8, pa3);
#undef PK4
}
template <int ND0, int VAR = 0> __device__ __forceinline__ void qkt(f32x16& p0, f32x16& p1, const char* Ks, const bf16x8* qr, int r32, int hi, const f32x16& negm) {
  p0 = negm; p1 = negm;
#pragma unroll
  for (int d0 = 0; d0 < ND0; ++d0) { int cb = (d0 * 16 + hi * 8) * 2;
    bf16x8 b0, b1;
    if (VAR & 4) { b0 = qr[d0]; b1 = qr[(d0 + 1) % ND0]; } else {
    b0 = *reinterpret_cast<const bf16x8*>(Ks + KSWZ(r32, cb));
    b1 = *reinterpret_cast<const bf16x8*>(Ks + KSWZ(32 + r32, cb)); }
    if (VAR & 16) { p0[d0] += (float)b0[0]; p1[d0] += (float)b1[1]; } else {
    p0 = __builtin_amdgcn_mfma_f32_32x32x16_bf16(b0, qr[d0], p0, 0, 0, 0);
    p1 = __builtin_amdgcn_mfma_f32_32x32x16_bf16(b1, qr[d0], p1, 0, 0, 0); } }
}
__device__ __forceinline__ int v_st(int k, int c) { const int kk = (k & ~0xC) | ((k & 4) << 1) | ((k & 8) >> 1); return ((kk >> 3) * 2 + (c >> 5)) * 512 + ((kk & 7) * 32 + (c & 31)) * 2; }
__device__ __forceinline__ int v_rd_base(int lane) { return ((lane & 3) << 3) | (((lane >> 2) & 3) << 6) | (((lane >> 4) & 1) << 5) | (((lane >> 5) & 1) << 8); }
constexpr int v_rd_off(int d0, int ks, int half) { return d0 * 512 + ks * 2048 + half * 1024; }
template <int OFF> __device__ __forceinline__ s16x4 tr_read(int vb) {
  s16x4 r; asm volatile("ds_read_b64_tr_b16 %0, %1 offset:%2" : "=&v"(r) : "v"(vb), "i"(OFF) : "memory"); return r;
}
template <int D0, int VAR = 0> __device__ __forceinline__ void pv_one(f32x16& od, int vb, bf16x8 pa0, bf16x8 pa1, bf16x8 pa2, bf16x8 pa3) {
  if (VAR & 8) {
    if (VAR & 16) { od[0] += (float)pa0[0]; od[1] += (float)pa1[0]; od[2] += (float)pa2[0]; od[3] += (float)pa3[0]; return; }
    od = __builtin_amdgcn_mfma_f32_32x32x16_bf16(pa0, pa1, od, 0, 0, 0); od = __builtin_amdgcn_mfma_f32_32x32x16_bf16(pa1, pa2, od, 0, 0, 0);
    od = __builtin_amdgcn_mfma_f32_32x32x16_bf16(pa2, pa3, od, 0, 0, 0); od = __builtin_amdgcn_mfma_f32_32x32x16_bf16(pa3, pa0, od, 0, 0, 0); return; }
  const s16x4 l0 = tr_read<v_rd_off(D0, 0, 0)>(vb), h0 = tr_read<v_rd_off(D0, 0, 1)>(vb), l1 = tr_read<v_rd_off(D0, 1, 0)>(vb), h1 = tr_read<v_rd_off(D0, 1, 1)>(vb);
  const s16x4 l2 = tr_read<v_rd_off(D0, 2, 0)>(vb), h2 = tr_read<v_rd_off(D0, 2, 1)>(vb), l3 = tr_read<v_rd_off(D0, 3, 0)>(vb), h3 = tr_read<v_rd_off(D0, 3, 1)>(vb);
  asm volatile("s_waitcnt lgkmcnt(0)" ::: "memory"); SBAR();
#define PK(L, H) (bf16x8){L[0], L[1], L[2], L[3], H[0], H[1], H[2], H[3]}
  od = __builtin_amdgcn_mfma_f32_32x32x16_bf16(pa0, PK(l0, h0), od, 0, 0, 0);
  od = __builtin_amdgcn_mfma_f32_32x32x16_bf16(pa1, PK(l1, h1), od, 0, 0, 0);
  od = __builtin_amdgcn_mfma_f32_32x32x16_bf16(pa2, PK(l2, h2), od, 0, 0, 0);
  od = __builtin_amdgcn_mfma_f32_32x32x16_bf16(pa3, PK(l3, h3), od, 0, 0, 0);
#undef PK
}
template <int VAR = 0> __device__ __forceinline__ void pv_d0(f32x16* o, int vb, bf16x8 pa0, bf16x8 pa1, bf16x8 pa2, bf16x8 pa3) {
  pv_one<0, VAR>(o[0], vb, pa0, pa1, pa2, pa3); pv_one<1, VAR>(o[1], vb, pa0, pa1, pa2, pa3);
}

struct AttnIO {
  const bf16_t* Q1;
  const bf16_t* Q2;
  const bf16_t* K1;
  const bf16_t* K2;
  const bf16_t* V;
  bf16_t* O;
};
template <bool SWA, int VAR = 0>
__device__ __forceinline__ void attn_unit(const AttnIO io, const int q0  , const float sink, char* lds, int tid_in) {
  constexpr int ND0 = SWA ? 4 : 6;
  constexpr int LDQ1 = 512, LDQ2 = 256, LDK1 = SWA ? 128 : 512, LDK2 = 32, LDV = SWA ? 128 : 512, LDO = 1024;
  constexpr float SCALE = SWA ? 0.125f : 0.10206207261596575f;
  int tid_ = tid_in; asm volatile("" : "+v"(tid_));
  const int tid = tid_, wid = tid >> 6, lane = tid & 63, r32 = lane & 31, hi = lane >> 5;
  char* V_lds = lds + OFF_V; char* K_lds = lds + OFF_K;
  float* ws = (float*)(lds + OFF_WS) + wid * 64; float* li_l = ws; float* al_l = ws + 32;
  float l_reg = 0; f32x16 o[2] = {}; bf16x8 qr[ND0];
  {
    const bf16_t* Qw = io.Q1 + (long)(wid * QBLK + r32) * LDQ1 + hi * 8;
#pragma unroll
    for (int d0 = 0; d0 < 4; ++d0) qr[d0] = *reinterpret_cast<const bf16x8*>(Qw + d0 * 16);
    if constexpr (!SWA) {
      const bf16_t* Qw2 = io.Q2 + (long)(wid * QBLK + r32) * LDQ2 + hi * 8;
#pragma unroll
      for (int d0 = 0; d0 < 2; ++d0) qr[4 + d0] = *reinterpret_cast<const bf16x8*>(Qw2 + d0 * 16);
    }
  }
  const int sr = tid >> 3, sc = (tid & 7) * 8, vst = v_st(sr, sc), kst = KSWZ(sr, sc * 2);
  const int sr2 = (tid & 255) >> 2, sc2 = (tid & 3) * 8, kst2 = KSWZ(sr2, (64 + sc2) * 2);
  const int vb0 = (int)(uintptr_t)V_lds + v_rd_base(lane);
  int NT, jlo = 0;
  if constexpr (SWA) { jlo = (q0 == 0) ? 2 : 0; NT = 4 + 8 - jlo - ((q0 == 4096 - 256) ? 2 : 0); } else NT = 68;
#define KEY0(t) (SWA ? ((t) < 4 ? (t) * 64 : 256 + q0 - 128 + ((t) - 4 + jlo) * 64) : (t) * 64)
  struct { bf16x8 v, k, k2; } sr_;
#define SLOAD(t) do { if (VAR & 2) break; const long k0_ = KEY0(t); sr_.v = *reinterpret_cast<const bf16x8*>(io.V + (k0_ + sr) * LDV + sc); \
    sr_.k = *reinterpret_cast<const bf16x8*>(io.K1 + (k0_ + sr) * LDK1 + sc); \
    if constexpr (!SWA) sr_.k2 = *reinterpret_cast<const bf16x8*>(io.K2 + (k0_ + sr2) * LDK2 + sc2); } while (0)
#define SWRITE(kb_, vb_) do { if (VAR & 2) break; *(bf16x8*)(V_lds + (vb_) * SHM_V + vst) = sr_.v; *(bf16x8*)(K_lds + (kb_) * SHM_K + kst) = sr_.k; \
    if constexpr (!SWA) { if (tid < 256) *(bf16x8*)(K_lds + (kb_) * SHM_K + kst2) = sr_.k2; } } while (0)
#define RESC(a) do { if (__any((a) < 1.f)) { if (hi == 0) al_l[r32] = (a); asm volatile("s_waitcnt lgkmcnt(0)" ::: "memory"); \
    _Pragma("unroll") for (int d = 0; d < 2; ++d) _Pragma("unroll") for (int r = 0; r < 16; ++r) o[d][r] *= al_l[crow(r, hi)]; } } while (0)
#define MASK(P0, P1, t) do { if constexpr (SWA) { if ((t) >= 4) { const int base_ = -128 + ((t) - 4 + jlo) * 64 - wid * QBLK - r32 + 4 * hi; \
    _Pragma("unroll") for (int r = 0; r < 16; ++r) { const int d_ = base_ + (r & 3) + 8 * (r >> 2); \
      if (d_ > 128 || d_ < -128) P0[r] = -INFINITY; if (d_ + 32 > 128 || d_ + 32 < -128) P1[r] = -INFINITY; } } } } while (0)
  f32x16 p0, p1; float al; bf16x8 pa0, pa1, pa2, pa3;
  const int half = __builtin_amdgcn_readfirstlane(wid >> 2);
  f32x16 negm = f32x16{}; asm volatile("" : "+v"(negm));
  float mref = 0.f; constexpr float THR2 = 8.f;
#define SOFTMAX(t, FIRST) do { MASK(p0, p1, t); \
    float pmax_ = p0[0]; _Pragma("unroll") for (int r = 1; r < 16; ++r) pmax_ = fmaxf(pmax_, p0[r]); _Pragma("unroll") for (int r = 0; r < 16; ++r) pmax_ = fmaxf(pmax_, p1[r]); \
    { auto rr = __builtin_amdgcn_permlane32_swap(__float_as_uint(pmax_), __float_as_uint(pmax_), false, false); pmax_ = fmaxf(__uint_as_float(rr[0]), __uint_as_float(rr[1])); } \
    al = 1.f; \
    if ((FIRST) || !__all(pmax_ <= THR2)) { const float dl_ = (FIRST) ? pmax_ : fmaxf(pmax_, 0.f); mref += dl_; al = (FIRST) ? 1.f : __builtin_amdgcn_exp2f(-dl_); \
      _Pragma("unroll") for (int r = 0; r < 16; ++r) { p0[r] -= dl_; p1[r] -= dl_; } \
      _Pragma("unroll") for (int r = 0; r < 16; ++r) negm[r] = -mref; asm volatile("" : "+v"(negm)); \
      if (!(FIRST)) RESC(al); } \
    _Pragma("unroll") for (int r = 0; r < 16; ++r) p0[r] = (VAR & 1) ? p0[r] * 0.001f : __builtin_amdgcn_exp2f(p0[r]); \
    finishSM<VAR>(p0, p1, al, l_reg, pa0, pa1, pa2, pa3); } while (0)
  SLOAD(0); asm volatile("s_waitcnt vmcnt(0)" ::: "memory"); SWRITE(0, 0); SLOAD(1); asm volatile("s_waitcnt vmcnt(0)" ::: "memory"); SWRITE(1, 1); if (2 < NT) SLOAD(2);
  __syncthreads();
  if (half) __syncthreads();
  int kc = 0, vp = 3;
  qkt<ND0, VAR>(p0, p1, K_lds, qr, r32, hi, negm);
  __syncthreads();
  SOFTMAX(0, true); if (2 < NT) SWRITE(2, 2); if (3 < NT) SLOAD(3);
  __syncthreads();
  for (int t = 1; t < NT; ++t) {
    kc = (kc == NKB - 1) ? 0 : kc + 1; vp = (vp == NVB - 1) ? 0 : vp + 1;
    SBAR(); pv_d0<VAR>(o, vb0 + vp * SHM_V, pa0, pa1, pa2, pa3);
    qkt<ND0, VAR>(p0, p1, K_lds + kc * SHM_K, qr, r32, hi, negm); SBAR();
    __syncthreads();
    SOFTMAX(t, false);
    if (t + 2 < NT) { int k2 = kc + 2; if (k2 >= NKB) k2 -= NKB; int v2 = vp + 3; if (v2 >= NVB) v2 -= NVB; SWRITE(k2, v2); }
    if (t + 3 < NT) SLOAD(t + 3);
    __syncthreads();
  }
  vp = (vp == NVB - 1) ? 0 : vp + 1;
  pv_d0<VAR>(o, vb0 + vp * SHM_V, pa0, pa1, pa2, pa3);
  if (!half) __syncthreads();
#undef SOFTMAX
  if constexpr (SWA) l_reg += __builtin_amdgcn_exp2f(sink * 1.4426950408889634f - mref);
  if (hi == 0) li_l[r32] = l_reg; asm volatile("s_waitcnt lgkmcnt(0)" ::: "memory");
  float rli[16];
#pragma unroll
  for (int r = 0; r < 16; ++r) rli[r] = __builtin_amdgcn_rcpf(li_l[crow(r, hi)]);
  { bf16_t* stg = (bf16_t*)(lds + OFF_OST) + wid * 2048;
#pragma unroll
    for (int r = 0; r < 16; ++r) { const int orow = crow(r, hi);
#pragma unroll
      for (int d0 = 0; d0 < 2; ++d0) stg[orow * 64 + d0 * 32 + r32] = (bf16_t)(cvtpk(o[d0][r] * rli[r], 0.f) & 0xffffu); }
    asm volatile("s_waitcnt lgkmcnt(0)" ::: "memory");
    bf16_t* Ow = io.O + (long)(wid * QBLK) * LDO;
#pragma unroll
    for (int i = 0; i < 4; ++i) { const int row = i * 8 + (lane >> 3), ch = lane & 7; const u32x4 v = *(const u32x4*)(stg + row * 64 + ch * 8); *(u32x4*)(Ow + (long)row * LDO + ch * 8) = v; } }
  __syncthreads();
#undef SLOAD
#undef SWRITE
#undef RESC
#undef MASK
#undef KEY0
}
#undef KSWZ
#undef SBAR
}
constexpr int NWAVES = 8;
constexpr int DM = 1024, NB = 8, SEQ = 4096, CTX = 256, TPB = SEQ + CTX  , RT = NB * TPB  , RL = NB * SEQ  ;
constexpr int DIN = 3232, DINP = 3328, DFF = 2816, DUP = 5632;
constexpr float EPS = 1e-6f;
constexpr size_t MiB = 1u << 20;
constexpr size_t WS_CTL = 0, CTL_ZERO_BYTES = 64 * 1024;
constexpr size_t WS_ROPE_S = 64 * 1024;
constexpr size_t WS_ROPE_M = WS_ROPE_S + 64 * 16 * 8;
constexpr size_t WS_MODF = 128 * 1024;
constexpr size_t WS_SSQ_Q = 512 * 1024;
constexpr size_t WS_SSQ_KV = WS_SSQ_Q + (size_t)RT * 16;
constexpr size_t WS_SSQ_16 = WS_SSQ_KV + (size_t)RT * 16;
constexpr size_t WS_MODP = 4 * MiB;
constexpr size_t WS_WIN = 8 * MiB;
constexpr size_t WS_WQ = WS_WIN + (size_t)DINP * 1024 * 2;
constexpr size_t WS_WKV = WS_WQ + 768 * 256 * 2;
constexpr size_t WS_WOAB = WS_WKV + 1024 * 256 * 2;
constexpr size_t WS_WOUT = WS_WOAB + 1024 * 1024 * 2;
constexpr size_t WS_WUP = WS_WOUT + 1024 * 1024 * 2;
constexpr size_t WS_WDN = WS_WUP + (size_t)DUP * 1024 * 2;
static_assert(WS_WDN + (size_t)1024 * DFF * 2 <= 40 * MiB, "weights");
constexpr size_t WS_H = 40 * MiB;
constexpr size_t WS_G = 108 * MiB;
constexpr size_t WS_QA = 244 * MiB, WS_KVR = 261 * MiB, WS_KR = 278 * MiB, WS_KS = 281 * MiB, WS_VS = 290 * MiB, WS_QS = 299 * MiB;
constexpr size_t WS_QN = 333 * MiB, WS_QR = 367 * MiB, WS_KN = 384 * MiB, WS_VM = 418 * MiB;
constexpr size_t WS_M1 = 452 * MiB;
constexpr size_t WS_END_REQ = 512 * MiB;
constexpr size_t WS_M1b = 244 * MiB;
constexpr size_t WS_AL = 312 * MiB;
constexpr size_t WS_SB = 312 * MiB;
constexpr size_t WS_F = 380 * MiB;
constexpr size_t WS_ACT = 108 * MiB;

constexpr int RING_BYTES = 131072, MISC_OFF = RING_BYTES + 320, LDS_BYTES = 147456;

#define GAS __attribute__((address_space(1)))
#define LAS __attribute__((address_space(3)))
typedef unsigned short bf16;
typedef unsigned v4u __attribute__((ext_vector_type(4)));
typedef unsigned v2u __attribute__((ext_vector_type(2)));
typedef float f32x4 __attribute__((ext_vector_type(4)));
#define LDS_WAIT() asm volatile("s_waitcnt lgkmcnt(0)" ::: "memory")
#define VM_WAIT() asm volatile("s_waitcnt vmcnt(0)" ::: "memory")
__device__ __forceinline__ unsigned pk2(float lo, float hi) { return att::cvtpk(lo, hi); }
__device__ __forceinline__ float bf2f(unsigned short b) { return __uint_as_float((unsigned)b << 16); }
__device__ __forceinline__ v2u pk4(f32x4 v) { v2u w; w.x = pk2(v[0], v[1]); w.y = pk2(v[2], v[3]); return w; }
__device__ __forceinline__ f32x4 unpk4(v2u w) { f32x4 v; v[0] = __uint_as_float(w.x << 16); v[1] = __uint_as_float(w.x & 0xffff0000u); v[2] = __uint_as_float(w.y << 16); v[3] = __uint_as_float(w.y & 0xffff0000u); return v; }

#define XB_TMO      128
#define XB_XCNT(j)  (256  + 64 * (j))
#define XB_XSUB(j)  (1280 + 64 * (j))
#define XB_XGEN(j)  (2304 + 64 * (j))
#define XB_TOP      3328
#define XB_TOPGEN   3392
#define XCD_BAR_WORDS 3456
#define XB_SPIN_CAP (1u << 22)
__device__ __forceinline__ unsigned xb_ld(unsigned* p)              { return __hip_atomic_load(p, __ATOMIC_RELAXED, __HIP_MEMORY_SCOPE_AGENT); }
__device__ __forceinline__ unsigned xb_add(unsigned* p, unsigned v) { return __hip_atomic_fetch_add(p, v, __ATOMIC_RELAXED, __HIP_MEMORY_SCOPE_AGENT); }
__device__ __forceinline__ unsigned xb_xcc_id() { return (unsigned)__builtin_amdgcn_s_getreg((3 << 11) | 20) & 0xFu; }
#define XB_SPIN(cond, bar) do { unsigned _sp = 0; while (cond) { __builtin_amdgcn_s_sleep(1); \
    if ((++_sp & 255u) == 0u) { if (xb_ld(&(bar)[XB_TMO])) break; if (_sp > XB_SPIN_CAP) { atomicAdd(&(bar)[XB_TMO], 1u); break; } } } } while (0)
struct XcdBarrier { unsigned* bar; unsigned x; volatile LAS unsigned* st; };
__device__ __forceinline__ XcdBarrier xcd_barrier_post(unsigned* bar, volatile LAS unsigned* st) {
    XcdBarrier b; b.bar = bar; b.x = xb_xcc_id(); b.st = st;
    if (threadIdx.x == 0) (void)xb_add(&bar[XB_XCNT(b.x)], 1u);
    return b;
}
__device__ __forceinline__ void xcd_barrier_complete(unsigned* bar, unsigned x, unsigned& nloc, unsigned& nx) {
    const unsigned G = gridDim.x * gridDim.y * gridDim.z;
    unsigned sum, cnt, mine, sp = 0u;
    for (;;) {
        sum = 0u; cnt = 0u; mine = 0u;
#pragma unroll
        for (unsigned j = 0; j < 16; ++j) { const unsigned c = xb_ld(&bar[XB_XCNT(j)]); sum += c; cnt += (c > 0u) ? 1u : 0u; mine = (j == x) ? c : mine; }
        if (sum == G) break;
        __builtin_amdgcn_s_sleep(1);
        if ((++sp & 255u) == 0u) { if (xb_ld(&bar[XB_TMO])) break; if (sp > XB_SPIN_CAP) { atomicAdd(&bar[XB_TMO], 1u); break; } }
    }
    nloc = mine > 0u ? mine : 1u; nx = cnt > 0u ? cnt : 1u;
}
__device__ __forceinline__ void xcd_barrier(const XcdBarrier& b) {
    asm volatile("s_waitcnt vmcnt(0)" ::: "memory");
    __syncthreads();
    if (threadIdx.x == 0) {
        unsigned* bar = b.bar;
        __builtin_amdgcn_s_waitcnt(0);
        unsigned nloc = b.st[0], nx = b.st[1];
        if (nloc == 0u) { xcd_barrier_complete(bar, b.x, nloc, nx); b.st[0] = nloc; b.st[1] = nx; }
        const unsigned old = xb_add(&bar[XB_XSUB(b.x)], 1u);
        const unsigned gen = old / nloc;
        if (old + 1u == (gen + 1u) * nloc) {
            __builtin_amdgcn_fence(__ATOMIC_RELEASE, "agent");
            asm volatile("s_waitcnt vmcnt(0)" ::: "memory");
            const unsigned og = xb_add(&bar[XB_TOP], 1u);
            const unsigned tg = og / nx;
            if (og + 1u == (tg + 1u) * nx) xb_add(&bar[XB_TOPGEN], 1u);
            else XB_SPIN(xb_ld(&bar[XB_TOPGEN]) == tg, bar);
            __builtin_amdgcn_fence(__ATOMIC_ACQUIRE, "agent");
            xb_add(&bar[XB_XGEN(b.x)], 1u);
            asm volatile("s_waitcnt vmcnt(0)" ::: "memory");
        } else {
            XB_SPIN(xb_ld(&bar[XB_XGEN(b.x)]) == gen, bar);
            __builtin_amdgcn_fence(__ATOMIC_ACQUIRE, "agent");
            asm volatile("s_waitcnt vmcnt(0)" ::: "memory");
        }
    }
    __syncthreads();
}

__device__ __forceinline__ float ssq4(f32x4 v) { return (v[0] * v[0] + v[1] * v[1]) + (v[2] * v[2] + v[3] * v[3]); }
__device__ __forceinline__ float wave_sum(float v) {
#pragma unroll
    for (int o = 1; o < 64; o <<= 1) v += __shfl_xor(v, o);
    return v;
}
__device__ __forceinline__ float silu_f(float v) { return v * __builtin_amdgcn_rcpf(1.f + __builtin_amdgcn_exp2f(-1.4426950408889634f * v)); }
__device__ __forceinline__ float sigmoid_f(float v) { return __builtin_amdgcn_rcpf(1.f + __builtin_amdgcn_exp2f(-1.4426950408889634f * v)); }

struct Args { const float* in[24]; float* out; unsigned char* ws; };
enum { I_X = 0, I_C, I_CTX, I_CCTX, I_WADA, I_BADA, I_APRE, I_APOST, I_WIN, I_BGATE, I_QNG, I_WQUP, I_KVNG, I_WKVUP, I_WOM, I_SINK, I_WOS, I_WOUT, I_FPRE, I_FPOST, I_WUP, I_CONVW, I_CONVB, I_WDN };
__device__ __forceinline__ void transpose_item(const float* W, int N, int k0, int n0, bf16* WT, int ldw, int drow0, int dk0, const float* gain, LAS float* scr, int lane, bool perm) {
#pragma unroll 8
    for (int i = 0; i < 32; ++i) { const int kk = 2 * i + (lane >> 5); float v = W[(size_t)(k0 + kk) * N + n0 + (lane & 31)]; if (gain) v *= gain[k0 + kk]; scr[kk * 33 + (lane & 31)] = v; }
    LDS_WAIT(); asm volatile("" ::: "memory");
    const int c = lane & 7;
#pragma unroll
    for (int j = 0; j < 4; ++j) { const int n = (lane >> 3) + 8 * j; const LAS float* s = scr + (8 * c) * 33 + n;
        v4u o; o.x = pk2(s[0 * 33], s[1 * 33]); o.y = pk2(s[2 * 33], s[3 * 33]); o.z = pk2(s[4 * 33], s[5 * 33]); o.w = pk2(s[6 * 33], s[7 * 33]);
        const int nr = perm ? 16 * ((n >> 2) & 1) + 4 * (n >> 3) + (n & 3) : n;
        *(GAS v4u*)(WT + (size_t)(drow0 + nr) * ldw + dk0 + k0 + 8 * c) = o; }
    LDS_WAIT(); asm volatile("" ::: "memory");
}
__device__ __forceinline__ int inproj_row(int n) {
    if (n < 416) return n;
    if (n < 928) return n - 416 + 768;
    if (n < 1056) return n - 928 + 512;
    if (n < 1184) return n - 1056 + 640;
    return n - 1184 + 1280;
}
__device__ __forceinline__ float inv_freq16(int f) {
    switch (f) { case 0: return 1.0f; case 1: return 0.5623413324356079f; case 2: return 0.3162277638912201f; case 3: return 0.17782793939113617f; case 4: return 0.10000000149011612f;
        case 5: return 0.05623413249850273f; case 6: return 0.03162277489900589f; case 7: return 0.017782794311642647f; case 8: return 0.009999999776482582f; case 9: return 0.005623413249850273f;
        case 10: return 0.003162277629598975f; case 11: return 0.0017782794311642647f; case 12: return 0.0010000000474974513f; case 13: return 0.000562341301701963f;
        case 14: return 0.0003162277571391314f; default: return 0.00017782794020604342f; }
}
__device__ __forceinline__ void sincos_acc(float ang, float& c, float& s) {
    const double a = (double)ang;
    const double k = __builtin_rint(a * 0.63661977236758134308);
    const double r = (a - k * 1.5707963267948966192) - k * 6.123233995736766e-17;
    const double r2 = r * r;
    const double sn = r * (1.0 + r2 * (-1.0 / 6 + r2 * (1.0 / 120 + r2 * (-1.0 / 5040 + r2 * (1.0 / 362880 + r2 * (-1.0 / 39916800 + r2 * (1.0 / 6227020800.0)))))));
    const double cs = 1.0 + r2 * (-0.5 + r2 * (1.0 / 24 + r2 * (-1.0 / 720 + r2 * (1.0 / 40320 + r2 * (-1.0 / 3628800 + r2 * (1.0 / 479001600.0 + r2 * (-1.0 / 87178291200.0)))))));
    const int q = ((int)k) & 3;
    const double cc = (q == 0) ? cs : (q == 1) ? -sn : (q == 2) ? -cs : sn;
    const double ss = (q == 0) ? sn : (q == 1) ? cs : (q == 2) ? -sn : -cs;
    c = (float)cc; s = (float)ss;
}
__device__ __forceinline__ void p0_prologue(const Args& a, LAS unsigned char* lds, int vcu, int G, int tid, int lane, int wave) {
    unsigned char* ws = a.ws;
    LAS float* scr = (LAS float*)(lds + wave * 16384);
    const int gw = vcu * NWAVES + wave, NGW = G * NWAVES;
    bf16* WIN = (bf16*)(ws + WS_WIN); bf16* WQ = (bf16*)(ws + WS_WQ); bf16* WKV = (bf16*)(ws + WS_WKV); bf16* WOAB = (bf16*)(ws + WS_WOAB);
    bf16* WOUT = (bf16*)(ws + WS_WOUT); bf16* WUP = (bf16*)(ws + WS_WUP); bf16* WDN = (bf16*)(ws + WS_WDN);
    constexpr int I_IN = 16 * (DIN / 32), I_Q = 4 * 24, I_KV = 2 * 32, I_OA = 8 * 32, I_OB = 8 * 32, I_OUT = 16 * 32, I_UP = 16 * (DUP / 32), I_DN = 44 * 32;
    constexpr int NITEMS = I_IN + I_Q + I_KV + I_OA + I_OB + I_OUT + I_UP + I_DN;
    for (int it = gw; it < NITEMS; it += NGW) {
        int r = it;
        if (r < I_IN) { const int nblk = DIN / 32, kb = r / nblk, nb = r % nblk; { const int dr = inproj_row(32 * nb); const bool pm_ = (dr < 384) || (dr >= 640 && dr < 768) || (dr >= 1280);
              transpose_item(a.in[I_WIN], DIN, 64 * kb, 32 * nb, WIN, 1024, dr, 0, nullptr, scr, lane, pm_); } continue; } r -= I_IN;
        if (r < I_Q) { const int kb = r / 24, nb = r % 24, n0 = 32 * nb, hd = n0 / 96, cc = n0 % 96; const int drow = cc < 64 ? hd * 64 + cc : 512 + hd * 32 + (cc - 64);
            transpose_item(a.in[I_WQUP], 768, 64 * kb, n0, WQ, 256, drow, 0, a.in[I_QNG], scr, lane, cc < 64); continue; } r -= I_Q;
        if (r < I_KV) { const int kb = r / 32, nb = r % 32, n0 = 32 * nb, hd = n0 / 128, cc = n0 % 128; const int drow = cc < 64 ? hd * 64 + cc : 512 + hd * 64 + (cc - 64);
            transpose_item(a.in[I_WKVUP], 1024, 64 * kb, n0, WKV, 256, drow, 0, a.in[I_KVNG], scr, lane, true); continue; } r -= I_KV;
        if (r < I_OA) { const int kb = r / 32, nb = r % 32; transpose_item(a.in[I_WOM], 1024, 64 * kb, 32 * nb, WOAB, 1024, 32 * nb, 0, nullptr, scr, lane, true); continue; } r -= I_OA;
        if (r < I_OB) { const int kb = r / 32, nb = r % 32; transpose_item(a.in[I_WOS], 1024, 64 * kb, 32 * nb, WOAB, 1024, 32 * nb, 512, nullptr, scr, lane, true); continue; } r -= I_OB;
        if (r < I_OUT) { const int kb = r / 32, nb = r % 32; transpose_item(a.in[I_WOUT], 1024, 64 * kb, 32 * nb, WOUT, 1024, 32 * nb, 0, nullptr, scr, lane, true); continue; } r -= I_OUT;
        if (r < I_UP) { const int nblk = DUP / 32, kb = r / nblk, nb = r % nblk, n0 = 32 * nb; const int drow = n0 < DFF ? (n0 / 128) * 256 + (n0 % 128) : ((n0 - DFF) / 128) * 256 + 128 + ((n0 - DFF) % 128);
            transpose_item(a.in[I_WUP], DUP, 64 * kb, n0, WUP, 1024, drow, 0, nullptr, scr, lane, true); continue; } r -= I_UP;
        { const int kb = r / 32, nb = r % 32; transpose_item(a.in[I_WDN], 1024, 64 * kb, 32 * nb, WDN, DFF, 32 * nb, 0, nullptr, scr, lane, true); }
    }
    { const int gt = vcu * 512 + tid, NTH = G * 512;
      for (int i = gt; i < 96 * 128; i += NTH) *(GAS v4u*)(WIN + (size_t)(416 + i / 128) * 1024 + (i % 128) * 8) = (v4u){0u, 0u, 0u, 0u};
      for (int i = gt; i < 1024 * 16; i += NTH) *(GAS v4u*)(WKV + (size_t)(i / 16) * 256 + 128 + (i % 16) * 8) = (v4u){0u, 0u, 0u, 0u};
      float2* RS = (float2*)(ws + WS_ROPE_S); float2* RM = (float2*)(ws + WS_ROPE_M);
      for (int i = gt; i < 64 * 16 + 64 * 8; i += NTH) {
          const bool sw = i < 64 * 16; const int j = sw ? i : i - 64 * 16; const int pos = sw ? j / 16 : j / 8, f = sw ? j % 16 : j % 8;
          const int f16 = sw ? f : 2 * f;
          const float inv = inv_freq16(f16);
          const float ang = (float)pos * inv; float c, s; sincos_acc(ang, c, s);
          if (sw) RS[j] = make_float2(c, s); else RM[j] = make_float2(c, s);
      }
    }
    { LAS float* sv = (LAS float*)(lds + wave * 16384 + 12288);
      float* MODP = (float*)(ws + WS_MODP); const float* wada = a.in[I_WADA];
      for (int task = gw; task < 96 * 16; task += NGW) {
          const int cg = task % 96, ks = task / 96, col = cg * 64 + lane, kk0 = ks * 64;
#pragma unroll
          for (int b = 0; b < 9; ++b) { const float cv = (b < 8) ? a.in[I_C][b * 1024 + kk0 + lane] : a.in[I_CCTX][kk0 + lane]; sv[b * 64 + lane] = silu_f(cv); }
          LDS_WAIT(); asm volatile("" ::: "memory");
          float acc[9];
#pragma unroll
          for (int b = 0; b < 9; ++b) acc[b] = 0.f;
#pragma unroll 8
          for (int k = 0; k < 64; ++k) { const float w = wada[(size_t)(kk0 + k) * 6144 + col];
#pragma unroll
              for (int b = 0; b < 9; ++b) acc[b] = fmaf(sv[b * 64 + k], w, acc[b]); }
#pragma unroll
          for (int b = 0; b < 9; ++b) MODP[(size_t)(ks * 9 + b) * 6144 + col] = acc[b];
          LDS_WAIT(); asm volatile("" ::: "memory");
      }
    }
}
__device__ __forceinline__ float mod_from_partials(const float* MODP, const float* bada, int b, int j) {
    float s = bada[j];
#pragma unroll
    for (int ks = 0; ks < 16; ++ks) s += MODP[(size_t)(ks * 9 + b) * 6144 + j];
    return s;
}

__device__ __forceinline__ void p1_norm_mod(const Args& a, LAS unsigned char* lds, int vcu, int G, int tid, int lane, int wave) {
    unsigned char* ws = a.ws; const float* MODP = (const float*)(ws + WS_MODP); float* MODF = (float*)(ws + WS_MODF);
    for (int i = vcu * 512 + tid; i < 9 * 6144; i += G * 512) MODF[i] = mod_from_partials(MODP, a.in[I_BADA], i / 6144, i % 6144);
    LAS float* msh = (LAS float*)lds;
    LAS float* msc = msh + 1024;
    LAS float* mg = msc + 1024;
    bf16* H = (bf16*)(ws + WS_H);
    const int rows_per = (RT + G - 1) / G;
    int r = vcu * rows_per; const int rend = (r + rows_per < RT) ? r + rows_per : RT;
    while (r < rend) {
        const int b = r / TPB, t = r % TPB; const bool ctx = t < CTX; const int seg_end = b * TPB + (ctx ? CTX : TPB); const int e = seg_end < rend ? seg_end : rend;
        const int mb = ctx ? 8 : b;
        __syncthreads();
        for (int j = tid; j < 1024; j += 512) { msh[j] = mod_from_partials(MODP, a.in[I_BADA], mb, j); msc[j] = 1.f + mod_from_partials(MODP, a.in[I_BADA], mb, 1024 + j); mg[j] = a.in[I_APRE][j]; }
        __syncthreads();
        for (int row0 = r + 2 * wave; row0 < e; row0 += 2 * NWAVES) {
            const bool two = row0 + 1 < e; const int row1 = two ? row0 + 1 : row0;
            const int t0 = row0 - b * TPB, t1 = row1 - b * TPB;
            const float* src0 = ctx ? a.in[I_CTX] + (size_t)(b * CTX + t0) * 1024 : a.in[I_X] + (size_t)(b * SEQ + t0 - CTX) * 1024;
            const float* src1 = ctx ? a.in[I_CTX] + (size_t)(b * CTX + t1) * 1024 : a.in[I_X] + (size_t)(b * SEQ + t1 - CTX) * 1024;
            const GAS f32x4* xr0 = (const GAS f32x4*)src0 + lane; const GAS f32x4* xr1 = (const GAS f32x4*)src1 + lane;
            f32x4 v0[4], v1[4]; float s0 = 0.f, s1 = 0.f;
#pragma unroll
            for (int j = 0; j < 4; ++j) { v0[j] = xr0[64 * j]; v1[j] = xr1[64 * j]; }
#pragma unroll
            for (int j = 0; j < 4; ++j) { s0 += ssq4(v0[j]); s1 += ssq4(v1[j]); }
            const float rstd0 = 1.f / sqrtf(wave_sum(s0) * (1.f / 1024.f) + EPS), rstd1 = 1.f / sqrtf(wave_sum(s1) * (1.f / 1024.f) + EPS);
            GAS v2u* o80 = (GAS v2u*)(H + (size_t)row0 * 1024) + lane; GAS v2u* o81 = (GAS v2u*)(H + (size_t)row1 * 1024) + lane;
#pragma unroll
            for (int j = 0; j < 4; ++j) { const int c0 = 4 * lane + 256 * j; f32x4 oa, ob;
#pragma unroll
                for (int i = 0; i < 4; ++i) { const float gg = mg[c0 + i] * msc[c0 + i], sh = msh[c0 + i]; oa[i] = (v0[j][i] * rstd0) * gg + sh; ob[i] = (v1[j][i] * rstd1) * gg + sh; }
                o80[64 * j] = pk4(oa); if (two) o81[64 * j] = pk4(ob); }
        }
        r = e;
    }
    __syncthreads();
}
typedef pg8::f32x4 (AccT)[2][2][4][2];
using pg8::Unit;
__device__ __forceinline__ void st4(bf16* p, f32x4 v) { *(GAS v2u*)p = pk4(v); }
__device__ __forceinline__ void st8(bf16* p, f32x4 a, f32x4 b) { v4u w; w.x = pk2(a[0], a[1]); w.y = pk2(a[2], a[3]); w.z = pk2(b[0], b[1]); w.w = pk2(b[2], b[3]); *(GAS v4u*)p = w; }
__device__ __forceinline__ void ld8(const bf16* p, f32x4& a, f32x4& b) { const v4u w = *(const GAS v4u*)p; a = unpk4((v2u){w.x, w.y}); b = unpk4((v2u){w.z, w.w}); }
__device__ __forceinline__ f32x4 shx32(f32x4 v) { f32x4 r; r[0] = __shfl_xor(v[0], 32); r[1] = __shfl_xor(v[1], 32); r[2] = __shfl_xor(v[2], 32); r[3] = __shfl_xor(v[3], 32); return r; }
__device__ __forceinline__ void rope_pair(f32x4& x0, f32x4& x1, const float2* cs) {
#pragma unroll
    for (int i = 0; i < 4; ++i) { const float c = cs[i].x, s = cs[i].y, a = x0[i], b = x1[i]; x0[i] = a * c - b * s; x1[i] = b * c + a * s; }
}

constexpr float QSCALE_MLA = 0.10206207261596575f * 1.4426950408889634f, QSCALE_SWA = 0.125f * 1.4426950408889634f;
struct EpiInProj {
    static constexpr int MID_T = 0;
    bf16 *QA, *KVR, *KR, *KS, *VS, *QS, *GT; float *SSQ_Q, *SSQ_KV; const float* b_gate; const float2* RS; const float2* RM;
    __device__ __forceinline__ void operator()(const AccT& acc, const Unit& u, int wr, int wc, int fr, int fq) const {
        const int tin = u.pm % 17; const bool ctx = (tin == 0);
        const int row0 = u.pm * 256 + wr * 64 + fr;
        const int pos0 = (tin - 1) * 256 + wr * 64 + fr;
        const int cw = wc * 32 + fq * 4;
        const int c8 = wc * 32 + fq * 8;
        if (u.pn == 0) {
#pragma unroll
            for (int ai = 0; ai < 2; ++ai)
#pragma unroll
                for (int m = 0; m < 4; ++m) { const int row = row0 + ai * 128 + m * 16; float s = 0.f;
#pragma unroll
                    for (int bj = 0; bj < 2; ++bj) { s += ssq4(acc[ai][bj][m][0]) + ssq4(acc[ai][bj][m][1]); st8(QA + (size_t)row * 256 + bj * 128 + c8, acc[ai][bj][m][0], acc[ai][bj][m][1]); }
                    s += __shfl_xor(s, 16); s += __shfl_xor(s, 32); if (fq == 0) SSQ_Q[(size_t)row * 4 + wc] = s; }
        } else if (u.pn == 1) {
#pragma unroll
            for (int ai = 0; ai < 2; ++ai)
#pragma unroll
                for (int m = 0; m < 4; ++m) { const int row = row0 + ai * 128 + m * 16; float s = 0.f;
                    s += ssq4(acc[ai][0][m][0]) + ssq4(acc[ai][0][m][1]); st8(KVR + (size_t)row * 256 + c8, acc[ai][0][m][0], acc[ai][0][m][1]);
#pragma unroll
                    for (int n = 0; n < 2; ++n) st4(KVR + (size_t)row * 256 + 128 + cw + n * 16, acc[ai][1][m][n]);
                    s += __shfl_xor(s, 16); s += __shfl_xor(s, 32); if (fq == 0) SSQ_KV[(size_t)row * 4 + wc] = s;
                    if (wc == 0) {
                        const int pos = pos0 + ai * 128 + m * 16;
#pragma unroll
                        for (int n = 0; n < 2; ++n) { f32x4 v = acc[ai][1][m][n]; const f32x4 p = shx32(v);
                            if (!ctx) { const int pi = (n == 0) ? (pos >> 6) : (pos & 63); const float2* cs = RM + pi * 8 + (fq & 1) * 4;
#pragma unroll
                                for (int i = 0; i < 4; ++i) v[i] = (fq < 2) ? v[i] * cs[i].x - p[i] * cs[i].y : v[i] * cs[i].x + p[i] * cs[i].y; }
                            st4(KR + (size_t)row * 32 + n * 16 + fq * 4, v); }
                    } }
        } else if (u.pn == 2) {
#pragma unroll
            for (int ai = 0; ai < 2; ++ai)
#pragma unroll
                for (int m = 0; m < 4; ++m) { const int row = row0 + ai * 128 + m * 16; const int pos = pos0 + ai * 128 + m * 16;
                    f32x4 x0 = acc[ai][0][m][0], x1 = acc[ai][0][m][1];
                    if (!ctx) { const int pi = (wc & 1) ? (pos & 63) : (pos >> 6); rope_pair(x0, x1, RS + pi * 16 + fq * 4); }
                    st4(KS + (size_t)row * 128 + cw, x0); st4(KS + (size_t)row * 128 + cw + 16, x1);
                    st8(VS + (size_t)row * 128 + c8, acc[ai][1][m][0], acc[ai][1][m][1]); }
        } else if (u.pn <= 4) {
            const int cb = (u.pn - 3) * 256;
#pragma unroll
            for (int ai = 0; ai < 2; ++ai)
#pragma unroll
                for (int m = 0; m < 4; ++m) { const int row = row0 + ai * 128 + m * 16; const int pos = pos0 + ai * 128 + m * 16;
                    const int pi = (wc & 1) ? (pos & 63) : (pos >> 6); const float2* cs = RS + pi * 16 + fq * 4;
#pragma unroll
                    for (int bj = 0; bj < 2; ++bj) { f32x4 x0 = acc[ai][bj][m][0] * QSCALE_SWA, x1 = acc[ai][bj][m][1] * QSCALE_SWA; rope_pair(x0, x1, cs);
                        st4(QS + (size_t)row * 512 + cb + bj * 128 + cw, x0); st4(QS + (size_t)row * 512 + cb + bj * 128 + cw + 16, x1); } }
        } else {
            const int cb = (u.pn - 5) * 256;
            f32x4 bv[2][2];
#pragma unroll
            for (int bj = 0; bj < 2; ++bj)
#pragma unroll
                for (int n = 0; n < 2; ++n) bv[bj][n] = *(const f32x4*)(b_gate + cb + bj * 128 + c8 + n * 4);
#pragma unroll
            for (int ai = 0; ai < 2; ++ai)
#pragma unroll
                for (int m = 0; m < 4; ++m) { const int row = row0 + ai * 128 + m * 16;
#pragma unroll
                    for (int bj = 0; bj < 2; ++bj) { f32x4 v0 = acc[ai][bj][m][0] + bv[bj][0], v1 = acc[ai][bj][m][1] + bv[bj][1];
#pragma unroll
                        for (int i = 0; i < 4; ++i) { v0[i] = sigmoid_f(v0[i]); v1[i] = sigmoid_f(v1[i]); }
                        st8(GT + (size_t)row * 2048 + cb + bj * 128 + c8, v0, v1); } }
        }
    }
};
struct EpiQUp {
    static constexpr int MID_T = 0;
    bf16 *QN, *QR; const float* SSQ_Q; const float2* RM;
    __device__ __forceinline__ void operator()(const AccT& acc, const Unit& u, int wr, int wc, int fr, int fq) const {
        const int tin = u.pm % 17; const int row0 = u.pm * 256 + wr * 64 + fr, pos0 = (tin - 1) * 256 + wr * 64 + fr, cw = wc * 32 + fq * 4;
#pragma unroll
        for (int ai = 0; ai < 2; ++ai)
#pragma unroll
            for (int m = 0; m < 4; ++m) { const int row = row0 + ai * 128 + m * 16; const int pos = pos0 + ai * 128 + m * 16;
                asm volatile("" ::: "memory"); __builtin_amdgcn_sched_barrier(0);
                const f32x4 sq = *(const f32x4*)(SSQ_Q + (size_t)row * 4); const float rs = QSCALE_MLA / sqrtf(((sq[0] + sq[1]) + (sq[2] + sq[3])) * (1.f / 256.f) + EPS);
                if (u.pn < 2) {
#pragma unroll
                    for (int bj = 0; bj < 2; ++bj) st8(QN + (size_t)row * 512 + u.pn * 256 + bj * 128 + wc * 32 + fq * 8, acc[ai][bj][m][0] * rs, acc[ai][bj][m][1] * rs);
                } else {
#pragma unroll
                    for (int bj = 0; bj < 2; ++bj)
#pragma unroll
                        for (int n = 0; n < 2; ++n) { f32x4 v = acc[ai][bj][m][n] * rs; const f32x4 p = shx32(v);
                            const int pi = (n == 0) ? (pos >> 6) : (pos & 63); const float2* cs = RM + pi * 8 + (fq & 1) * 4;
#pragma unroll
                            for (int i = 0; i < 4; ++i) v[i] = (fq < 2) ? v[i] * cs[i].x - p[i] * cs[i].y : v[i] * cs[i].x + p[i] * cs[i].y;
                            st4(QR + (size_t)row * 256 + (bj * 4 + wc) * 32 + n * 16 + fq * 4, v); }
                } }
    }
};
struct EpiKVUp {
    static constexpr int MID_T = 0;
    bf16 *KN, *VM; const float* SSQ_KV;
    __device__ __forceinline__ void operator()(const AccT& acc, const Unit& u, int wr, int wc, int fr, int fq) const {
        const int row0 = u.pm * 256 + wr * 64 + fr, cw = wc * 32 + fq * 4;
        bf16* dst = (u.pn < 2) ? KN + u.pn * 256 : VM + (u.pn - 2) * 256;
#pragma unroll
        for (int ai = 0; ai < 2; ++ai)
#pragma unroll
            for (int m = 0; m < 4; ++m) { const int row = row0 + ai * 128 + m * 16;
                asm volatile("" ::: "memory"); __builtin_amdgcn_sched_barrier(0);
                const f32x4 sq = *(const f32x4*)(SSQ_KV + (size_t)row * 4); const float rs = 1.f / sqrtf(((sq[0] + sq[1]) + (sq[2] + sq[3])) * (1.f / 128.f) + EPS);
#pragma unroll
                for (int bj = 0; bj < 2; ++bj) st8(dst + (size_t)row * 512 + bj * 128 + wc * 32 + fq * 8, acc[ai][bj][m][0] * rs, acc[ai][bj][m][1] * rs); }
    }
};
struct EpiMerge {
    static constexpr int MID_T = 8;
    bf16* M1; const bf16* GT;
    __device__ __forceinline__ void mid(AccT& acc, const Unit& u, int wr, int wc, int fr, int fq) const {
        const int row0 = u.pm * 256 + wr * 64 + fr, c0 = u.pn * 256 + wc * 32 + fq * 8;
#pragma unroll
        for (int ai = 0; ai < 2; ++ai)
#pragma unroll
            for (int m = 0; m < 4; ++m) { const int row = row0 + ai * 128 + m * 16;
#pragma unroll
                for (int bj = 0; bj < 2; ++bj) { const int col = c0 + bj * 128;
                    f32x4 ga0, ga1, gb0, gb1; ld8(GT + (size_t)row * 2048 + col, ga0, ga1); ld8(GT + (size_t)row * 2048 + 1024 + col, gb0, gb1);
#pragma unroll
                    for (int i = 0; i < 4; ++i) { acc[ai][bj][m][0][i] *= ga0[i] * __builtin_amdgcn_rcpf(fmaxf(gb0[i], 1e-18f)); acc[ai][bj][m][1][i] *= ga1[i] * __builtin_amdgcn_rcpf(fmaxf(gb1[i], 1e-18f)); } } }
    }
    __device__ __forceinline__ void operator()(const AccT& acc, const Unit& u, int wr, int wc, int fr, int fq) const {
        const int row0 = u.pm * 256 + wr * 64 + fr, c0 = u.pn * 256 + wc * 32 + fq * 8;
#pragma unroll
        for (int ai = 0; ai < 2; ++ai)
#pragma unroll
            for (int m = 0; m < 4; ++m) { const int row = row0 + ai * 128 + m * 16;
#pragma unroll
                for (int bj = 0; bj < 2; ++bj) { const int col = c0 + bj * 128;
                    f32x4 gb0, gb1, o0, o1; ld8(GT + (size_t)row * 2048 + 1024 + col, gb0, gb1);
#pragma unroll
                    for (int i = 0; i < 4; ++i) { o0[i] = fmaxf(gb0[i], 1e-18f) * acc[ai][bj][m][0][i]; o1[i] = fmaxf(gb1[i], 1e-18f) * acc[ai][bj][m][1][i]; }
                    st8(M1 + (size_t)row * 1024 + col, o0, o1); } }
    }
};
struct EpiOutSsq {
    static constexpr int MID_T = 0;
    bf16* O; float* SSQ;
    __device__ __forceinline__ void operator()(const AccT& acc, const Unit& u, int wr, int wc, int fr, int fq) const {
        const int row0 = u.pm * 256 + wr * 64 + fr, c0 = u.pn * 256 + wc * 32 + fq * 8;
#pragma unroll
        for (int ai = 0; ai < 2; ++ai)
#pragma unroll
            for (int m = 0; m < 4; ++m) { const int row = row0 + ai * 128 + m * 16; float s = 0.f;
#pragma unroll
                for (int bj = 0; bj < 2; ++bj) { s += ssq4(acc[ai][bj][m][0]) + ssq4(acc[ai][bj][m][1]); st8(O + (size_t)row * 1024 + c0 + bj * 128, acc[ai][bj][m][0], acc[ai][bj][m][1]); }
                s += __shfl_xor(s, 16); s += __shfl_xor(s, 32); if (fq == 0) SSQ[(size_t)row * 16 + u.pn * 4 + wc] = s; }
    }
};
__device__ __forceinline__ f32x4 bperm4(int addr, f32x4 v) { f32x4 r;
#pragma unroll
    for (int i = 0; i < 4; ++i) r[i] = __int_as_float(__builtin_amdgcn_ds_bpermute(addr, __float_as_int(v[i])));
    return r; }
template <int CTRL> __device__ __forceinline__ f32x4 dpp4(f32x4 v) { f32x4 r;
#pragma unroll
    for (int i = 0; i < 4; ++i) r[i] = __int_as_float(__builtin_amdgcn_update_dpp(0, __float_as_int(v[i]), CTRL, 0xf, 0xf, false));
    return r; }
#ifndef DPP_PREV
#define DPP_PREV 0x121
#define DPP_NEXT 0x12F
#endif
__device__ __forceinline__ f32x4 sel4(bool c, f32x4 a, f32x4 b) { f32x4 r;
#pragma unroll
    for (int i = 0; i < 4; ++i) r[i] = c ? a[i] : b[i];
    return r; }
struct EpiNull {
    static constexpr int MID_T = 0; float* O;
    __device__ __forceinline__ void operator()(const AccT& acc, const Unit& u, int wr, int wc, int fr, int fq) const {
        f32x4 s = acc[0][0][0][0];
#pragma unroll
        for (int ai = 0; ai < 2; ++ai)
#pragma unroll
            for (int bj = 0; bj < 2; ++bj)
#pragma unroll
                for (int m = 0; m < 4; ++m)
#pragma unroll
                    for (int n = 0; n < 2; ++n) s = s + acc[ai][bj][m][n];
        if (s[0] + s[1] + s[2] + s[3] == 12345.678f) O[(u.pm * 4 + u.pn) * 512 + (wr * 4 + wc) * 64 + fq * 16 + fr] = s[0];
    }
};
struct EpiUp {
    static constexpr int MID_T = 0;
    bf16* ACT; float* SB; const float* cw; const float* cb;
    __device__ __forceinline__ void operator()(AccT& acc, const Unit& u, int wr, int wc, int fr, int fq) const {
        const int lane = fq * 16 + fr;
        const int src_prev = ((lane & 48) | ((fr + 15) & 15)) << 2, src_next = ((lane & 48) | ((fr + 1) & 15)) << 2; (void)src_prev; (void)src_next;
        const int bat = u.pm / 17, tin = u.pm % 17;
        const int colw = wc * 32 + fq * 8;
        const bool lo = fr < 2, bnd = lo || fr >= 14; const int which = lo ? fr : fr - 12;
        const bool f0 = (fr == 0), f15 = (fr == 15);
#pragma unroll
        for (int ai = 0; ai < 2; ++ai) {
            const int chunk = (bat * SEQ + (tin - 1) * 256 + ai * 128 + wr * 64) >> 6;
            if (bnd) {
                float* sb = SB + ((size_t)chunk * 4 + which) * DUP + u.pn * 256 + colw;
#pragma unroll
                for (int bj = 0; bj < 2; ++bj)
#pragma unroll
                    for (int n = 0; n < 2; ++n) *(GAS f32x4*)(sb + bj * 128 + n * 4) = lo ? acc[ai][bj][0][n] : acc[ai][bj][3][n];
            }
            const size_t rowb = (size_t)(u.pm * 256 + ai * 128 + wr * 64 + fr);
#pragma unroll
            for (int n = 0; n < 2; ++n) {
#pragma unroll
                for (int bj = 0; bj < 2; ++bj) {
                    asm volatile("" ::: "memory"); __builtin_amdgcn_sched_barrier(0);
                    const int oc = bj * DFF + u.pn * 128 + colw + n * 4;
                    const f32x4 w0 = *(const f32x4*)(cw + oc), w1 = *(const f32x4*)(cw + DUP + oc), w2 = *(const f32x4*)(cw + 2 * DUP + oc), bb = *(const f32x4*)(cb + oc);
                    const f32x4 a0 = acc[ai][bj][0][n], a1 = acc[ai][bj][1][n], a2 = acc[ai][bj][2][n], a3 = acc[ai][bj][3][n];
#ifdef CONV_BPERMUTE
                    const f32x4 p0 = bperm4(src_prev, a0), p1 = bperm4(src_prev, a1), p2 = bperm4(src_prev, a2), p3 = bperm4(src_prev, a3);
                    const f32x4 n0 = bperm4(src_next, a0), n1 = bperm4(src_next, a1), n2 = bperm4(src_next, a2), n3 = bperm4(src_next, a3);
#else
                    const f32x4 p0 = dpp4<DPP_PREV>(a0), p1 = dpp4<DPP_PREV>(a1), p2 = dpp4<DPP_PREV>(a2), p3 = dpp4<DPP_PREV>(a3);
                    const f32x4 n0 = dpp4<DPP_NEXT>(a0), n1 = dpp4<DPP_NEXT>(a1), n2 = dpp4<DPP_NEXT>(a2), n3 = dpp4<DPP_NEXT>(a3);
#endif
                    acc[ai][bj][0][n] = bb + w0 * sel4(f0, p3, p0) + w1 * a0 + w2 * sel4(f15, n1, n0);
                    acc[ai][bj][1][n] = bb + w0 * sel4(f0, p0, p1) + w1 * a1 + w2 * sel4(f15, n2, n1);
                    acc[ai][bj][2][n] = bb + w0 * sel4(f0, p1, p2) + w1 * a2 + w2 * sel4(f15, n3, n2);
                    acc[ai][bj][3][n] = bb + w0 * sel4(f0, p2, p3) + w1 * a3 + w2 * sel4(f15, n0, n3);
                }
            }
            asm volatile("" ::: "memory"); __builtin_amdgcn_sched_barrier(0);
#pragma unroll
            for (int m = 0; m < 4; ++m) {
                f32x4 o0, o1;
#pragma unroll
                for (int i = 0; i < 4; ++i) { o0[i] = silu_f(acc[ai][0][m][0][i]) * acc[ai][1][m][0][i]; o1[i] = silu_f(acc[ai][0][m][1][i]) * acc[ai][1][m][1][i]; }
                st8(ACT + (rowb + m * 16) * DFF + u.pn * 128 + colw, o0, o1);
            }
        }
    }
};
__device__ __forceinline__ void p4_attention(const Args& a, char* lds, int vcu, int tid) {
    unsigned char* ws = a.ws;
    const bf16* QN = (const bf16*)(ws + WS_QN); const bf16* QR = (const bf16*)(ws + WS_QR); const bf16* KN = (const bf16*)(ws + WS_KN); const bf16* KR = (const bf16*)(ws + WS_KR); const bf16* VM = (const bf16*)(ws + WS_VM);
    const bf16* QS = (const bf16*)(ws + WS_QS); const bf16* KS = (const bf16*)(ws + WS_KS); const bf16* VS = (const bf16*)(ws + WS_VS); bf16* O2 = (bf16*)(ws + WS_H);
#ifndef REP_MLA
#define REP_MLA 1
#endif
#ifndef REP_SWA
#define REP_SWA 1
#endif
    for (int i = 0; i < 4 * REP_MLA; ++i) {
        const int unit = (i & 3) * 256 + vcu; if (unit >= 1024) break;
        const int bh = unit >> 4, qb = unit & 15, b = bh >> 3, h = bh & 7;
        const size_t krow0 = (size_t)b * TPB, qrow0 = krow0 + CTX + qb * 256;
        att::AttnIO io;
        io.Q1 = QN + qrow0 * 512 + h * 64; io.Q2 = QR + qrow0 * 256 + h * 32;
        io.K1 = KN + krow0 * 512 + h * 64; io.K2 = KR + krow0 * 32;
        io.V = VM + krow0 * 512 + h * 64; io.O = O2 + qrow0 * 1024 + h * 64;
        att::attn_unit<false>(io, qb * 256, 0.f, lds, tid);
    }
#ifdef XVAR
    for (int i = 0; i < 4; ++i) {
        const int unit = i * 256 + vcu; if (unit >= 1024) break;
        const int bh = unit >> 4, qb = unit & 15, b = bh >> 3, h = bh & 7;
        const size_t krow0 = (size_t)b * TPB, qrow0 = krow0 + CTX + qb * 256;
        att::AttnIO io;
        io.Q1 = QN + qrow0 * 512 + h * 64; io.Q2 = QR + qrow0 * 256 + h * 32;
        io.K1 = KN + krow0 * 512 + h * 64; io.K2 = KR + krow0 * 32;
        io.V = VM + krow0 * 512 + h * 64; io.O = (bf16*)(ws + WS_F) + qrow0 * 1024 + h * 64;
        att::attn_unit<false, XVAR>(io, qb * 256, 0.f, lds, tid);
    }
#endif
    for (int i = 0; i < 4 * REP_SWA; ++i) {
        const int unit = (i & 3) * 256 + vcu; if (unit >= 1024) break;
        const int bh = unit >> 4, qb = unit & 15, b = bh >> 3, h = bh & 7, kvh = h >> 2;
        const size_t krow0 = (size_t)b * TPB, qrow0 = krow0 + CTX + qb * 256;
        att::AttnIO io;
        io.Q1 = QS + qrow0 * 512 + h * 64; io.Q2 = nullptr;
        io.K1 = KS + krow0 * 128 + kvh * 64; io.K2 = nullptr;
        io.V = VS + krow0 * 128 + kvh * 64; io.O = O2 + qrow0 * 1024 + 512 + h * 64;
        att::attn_unit<true>(io, qb * 256, a.in[I_SINK][h], lds, tid);
    }
}
__device__ __forceinline__ void p7_resid_norm(const Args& a, LAS unsigned char* lds, int vcu, int G, int tid, int lane, int wave) {
    unsigned char* ws = a.ws; const float* MODF = (const float*)(ws + WS_MODF); const bf16* AL = (const bf16*)(ws + WS_AL); const float* SSQ = (const float*)(ws + WS_SSQ_16); bf16* HF = (bf16*)(ws + WS_H);
    LAS float* vpg = (LAS float*)lds; LAS float* vg1 = vpg + 1024; LAS float* vfg = vg1 + 1024; LAS float* vsh = vfg + 1024; LAS float* vsc = vsh + 1024;
    const int rows_per = (RL + G - 1) / G;
    int r = vcu * rows_per; const int rend = (r + rows_per < RL) ? r + rows_per : RL;
    while (r < rend) {
        const int b = r / SEQ; const int seg_end = (b + 1) * SEQ; const int e = seg_end < rend ? seg_end : rend;
        __syncthreads();
        for (int j = tid; j < 1024; j += 512) { vpg[j] = a.in[I_APOST][j]; vg1[j] = MODF[b * 6144 + 2048 + j]; vfg[j] = a.in[I_FPRE][j]; vsh[j] = MODF[b * 6144 + 3072 + j]; vsc[j] = 1.f + MODF[b * 6144 + 4096 + j]; }
        __syncthreads();
        for (int rl = r + wave; rl < e; rl += NWAVES) {
            const size_t row = (size_t)b * TPB + CTX + (rl - b * SEQ);
            const f32x4* sp = (const f32x4*)(SSQ + row * 16); const f32x4 s0 = sp[0], s1 = sp[1], s2 = sp[2], s3 = sp[3];
            const float ssq = ((s0[0] + s0[1]) + (s0[2] + s0[3])) + ((s1[0] + s1[1]) + (s1[2] + s1[3])) + ((s2[0] + s2[1]) + (s2[2] + s2[3])) + ((s3[0] + s3[1]) + (s3[2] + s3[3]));
            const float rstd1 = 1.f / sqrtf(ssq * (1.f / 1024.f) + EPS);
            const GAS f32x4* xr = (const GAS f32x4*)(a.in[I_X] + (size_t)rl * 1024) + lane; GAS f32x4* xo = (GAS f32x4*)(a.out + (size_t)rl * 1024) + lane;
            const GAS v2u* ar = (const GAS v2u*)(AL + row * 1024) + lane;
            f32x4 v[4]; float s = 0.f;
#pragma unroll
            for (int j = 0; j < 4; ++j) { const int c0 = 4 * lane + 256 * j; const f32x4 x = xr[64 * j]; const f32x4 al = unpk4(ar[64 * j]);
#pragma unroll
                for (int i = 0; i < 4; ++i) v[j][i] = x[i] + vg1[c0 + i] * (al[i] * rstd1 * vpg[c0 + i]);
                xo[64 * j] = v[j]; s += ssq4(v[j]); }
            const float rstd2 = 1.f / sqrtf(wave_sum(s) * (1.f / 1024.f) + EPS);
            GAS v2u* o8 = (GAS v2u*)(HF + row * 1024) + lane;
#pragma unroll
            for (int j = 0; j < 4; ++j) { const int c0 = 4 * lane + 256 * j; f32x4 o;
#pragma unroll
                for (int i = 0; i < 4; ++i) o[i] = (v[j][i] * rstd2 * vfg[c0 + i]) * vsc[c0 + i] + vsh[c0 + i];
                o8[64 * j] = pk4(o); }
        }
        r = e;
    }
    __syncthreads();
}
__device__ __forceinline__ void p9_conv_fix(const Args& a, int vcu, int G, int lane, int wave) {
    unsigned char* ws = a.ws; const float* SB = (const float*)(ws + WS_SB); bf16* ACT = (bf16*)(ws + WS_ACT); const float* cw = a.in[I_CONVW]; const float* cb = a.in[I_CONVB];
    const int gw = vcu * NWAVES + wave, NGW = G * NWAVES;
    for (int task = gw; task < 2 * 512; task += NGW) {
        const int chunk = task >> 1, last = task & 1;
        const int t = chunk * 64 + (last ? 63 : 0);
        const int b = t / SEQ, pos = t % SEQ; const size_t row = (size_t)b * TPB + CTX + pos;
        const float* cur = SB + ((size_t)chunk * 4 + (last ? 3 : 0)) * DUP;
        const float* prv = last ? SB + ((size_t)chunk * 4 + 2) * DUP : (pos == 0 ? nullptr : SB + ((size_t)(chunk - 1) * 4 + 3) * DUP);
        const float* nxt = last ? (pos == SEQ - 1 ? nullptr : SB + ((size_t)(chunk + 1) * 4 + 0) * DUP) : SB + ((size_t)chunk * 4 + 1) * DUP;
        for (int cc = lane; cc < DFF; cc += 64) {
            const int pg = (cc >> 7) * 256 + (cc & 127), pv = pg + 128;
            const float gp = prv ? prv[pg] : 0.f, gc = cur[pg], gn = nxt ? nxt[pg] : 0.f, vp = prv ? prv[pv] : 0.f, vc = cur[pv], vn = nxt ? nxt[pv] : 0.f;
            const float ug = cb[cc] + cw[cc] * gp + cw[DUP + cc] * gc + cw[2 * DUP + cc] * gn;
            const float uv = cb[DFF + cc] + cw[DFF + cc] * vp + cw[DUP + DFF + cc] * vc + cw[2 * DUP + DFF + cc] * vn;
            ACT[row * DFF + cc] = (bf16)(pk2(silu_f(ug) * uv, 0.f) & 0xffffu);
        }
    }
}
#ifndef EXP_FFN_SCALE
#define EXP_FFN_SCALE 1.f
#endif
__device__ __forceinline__ void p11_final(const Args& a, LAS unsigned char* lds, int vcu, int G, int tid, int lane, int wave) {
    unsigned char* ws = a.ws; const float* MODF = (const float*)(ws + WS_MODF); const bf16* F = (const bf16*)(ws + WS_F); const float* SSQ = (const float*)(ws + WS_SSQ_16);
    LAS float* vpg = (LAS float*)lds; LAS float* vg2 = vpg + 1024;
    const int rows_per = (RL + G - 1) / G;
    int r = vcu * rows_per; const int rend = (r + rows_per < RL) ? r + rows_per : RL;
    while (r < rend) {
        const int b = r / SEQ; const int seg_end = (b + 1) * SEQ; const int e = seg_end < rend ? seg_end : rend;
        __syncthreads();
        for (int j = tid; j < 1024; j += 512) { vpg[j] = a.in[I_FPOST][j]; vg2[j] = MODF[b * 6144 + 5120 + j]; }
        __syncthreads();
        for (int rl = r + wave; rl < e; rl += NWAVES) {
            const size_t row = (size_t)b * TPB + CTX + (rl - b * SEQ);
            const f32x4* sp = (const f32x4*)(SSQ + row * 16); const f32x4 s0 = sp[0], s1 = sp[1], s2 = sp[2], s3 = sp[3];
            const float ssq = ((s0[0] + s0[1]) + (s0[2] + s0[3])) + ((s1[0] + s1[1]) + (s1[2] + s1[3])) + ((s2[0] + s2[1]) + (s2[2] + s2[3])) + ((s3[0] + s3[1]) + (s3[2] + s3[3]));
            const float rstd = 1.f / sqrtf(ssq * (1.f / 1024.f) + EPS);
            GAS f32x4* xo = (GAS f32x4*)(a.out + (size_t)rl * 1024) + lane; const GAS v2u* fr_ = (const GAS v2u*)(F + row * 1024) + lane;
#pragma unroll
            for (int j = 0; j < 4; ++j) { const int c0 = 4 * lane + 256 * j; f32x4 x = xo[64 * j]; const f32x4 f = unpk4(fr_[64 * j]);
#pragma unroll
                for (int i = 0; i < 4; ++i) x[i] = x[i] + EXP_FFN_SCALE * vg2[c0 + i] * (f[i] * rstd * vpg[c0 + i]);
                xo[64 * j] = x; }
        }
        r = e;
    }
}

__device__ __forceinline__ int lane_id_volatile() { int l; asm volatile("v_mbcnt_lo_u32_b32 %0, -1, 0\n\tv_mbcnt_hi_u32_b32 %0, -1, %0" : "=v"(l)); return l; }

#ifdef DEBUG_FFN
constexpr int DBG_W = 8192;
__device__ __forceinline__ unsigned dbg_hash(unsigned x) { x ^= x >> 16; x *= 0x7feb352du; x ^= x >> 15; x *= 0x846ca68bu; x ^= x >> 16; return x; }
__device__ __forceinline__ void dbg_check_act(const Args& a, int vcu, int G, int lane, int wave) {
    unsigned char* ws = a.ws; const bf16* HF = (const bf16*)(ws + WS_H); const bf16* ACT = (const bf16*)(ws + WS_ACT); unsigned* ctl = (unsigned*)(ws + WS_CTL);
    const float* wup = a.in[I_WUP]; const float* cw = a.in[I_CONVW]; const float* cb = a.in[I_CONVB];
    const int s = vcu * NWAVES + wave;
    const unsigned h1 = dbg_hash(s * 3 + 1), h2 = dbg_hash(s * 3 + 2), h3 = dbg_hash(s * 3 + 3);
    const int type = s % 5, chunk = h1 % 512;
    int ric = 0;
    if (type == 0) ric = 16 * (h2 % 4) + 1 + (h3 % 14); else if (type == 1) ric = 16 * (1 + h2 % 3); else if (type == 2) ric = 16 * (h2 % 3) + 15; else if (type == 3) ric = 0; else ric = 63;
    const int t = chunk * 64 + ric, b = t / SEQ, pos = t % SEQ, cc = (h3 >> 8) % DFF;
    float ug = cb[cc], uv = cb[DFF + cc];
    for (int j = 0; j < 3; ++j) {
        const int pp = pos + j - 1; if (pp < 0 || pp >= SEQ) continue;
        const bf16* hr = HF + ((size_t)b * TPB + CTX + pp) * 1024;
        float sg = 0.f, sv = 0.f;
        for (int k = lane; k < 1024; k += 64) { const float hv = bf2f(hr[k]); sg += hv * wup[(size_t)k * DUP + cc]; sv += hv * wup[(size_t)k * DUP + DFF + cc]; }
        sg = wave_sum(sg); sv = wave_sum(sv);
        ug += cw[j * DUP + cc] * sg; uv += cw[j * DUP + DFF + cc] * sv;
    }
    const float ref = silu_f(ug) * uv; const float got = bf2f(ACT[((size_t)b * TPB + CTX + pos) * DFF + cc]);
    const float d = fabsf(ref - got);
    if (lane == 0) { if (d > 0.03f + 0.03f * fabsf(ref)) atomicOr(ctl + DBG_W, 1u << type); atomicMax(ctl + DBG_W + 1, (unsigned)(d * 1000.f)); }
}
#endif
__global__ void __launch_bounds__(NWAVES * 64, 2) fwd_kernel(Args args) {
    extern __shared__ __attribute__((aligned(16))) unsigned char lds_raw[];
    LAS unsigned char* lds = (LAS unsigned char*)lds_raw;
    volatile LAS unsigned* MISC = (volatile LAS unsigned*)(lds + MISC_OFF);
    const int tid0 = threadIdx.x; const int wave0 = __builtin_amdgcn_readfirstlane(tid0 >> 6);
#define TID() (wave0 * 64 + lane_id_volatile())
    const int G = gridDim.x; const int bx = blockIdx.x; const int vcu = (G % 8 == 0) ? (bx % 8) * (G / 8) + bx / 8 : bx;
    unsigned char* ws = args.ws;
    for (int u = tid0; u < (LDS_BYTES - RING_BYTES) / 4; u += NWAVES * 64) ((LAS unsigned*)(lds + RING_BYTES))[u] = 0u;
    __syncthreads();
    XcdBarrier bar = xcd_barrier_post((unsigned*)(ws + WS_CTL), MISC + 8);
#define GRID_BAR() xcd_barrier(bar)
#ifndef REP_PHASE
#define REP_PHASE -1
#endif
#ifndef REP_COUNT
#define REP_COUNT 2
#endif
#define REPS(n) ((n) == REP_PHASE ? REP_COUNT : 1)
    bf16* H = (bf16*)(ws + WS_H);
#define PH(n) (!defined(ONLY) || ONLY == (n))
    asm volatile("; PHASE_MARK 0");
#if !defined(ONLY) || ONLY == 0
    for (int rep_ = 0; rep_ < REPS(0); ++rep_) { if (rep_) GRID_BAR();
    { int tid = TID(); asm volatile("" : "+v"(tid)); const int lane = tid & 63, wave = __builtin_amdgcn_readfirstlane(tid >> 6); p0_prologue(args, lds, vcu, G, tid, lane, wave); }
    }
#endif
    GRID_BAR();
    asm volatile("; PHASE_MARK 1");
#if !defined(ONLY) || ONLY == 1
    for (int rep_ = 0; rep_ < REPS(1); ++rep_) { if (rep_) GRID_BAR();
    { int tid = TID(); asm volatile("" : "+v"(tid)); const int lane = tid & 63, wave = __builtin_amdgcn_readfirstlane(tid >> 6); p1_norm_mod(args, lds, vcu, G, tid, lane, wave); }
    }
#endif
    GRID_BAR();
    asm volatile("; PHASE_MARK 2");
#if !defined(ONLY) || ONLY == 2
    for (int rep_ = 0; rep_ < REPS(2); ++rep_) { if (rep_) GRID_BAR();
    {
        pg8::Gemm g{H, (const bf16*)(ws + WS_WIN), 1024, 1024, 1024}; pg8::Order<2> S{13, G, bx};
        EpiInProj E{(bf16*)(ws + WS_QA), (bf16*)(ws + WS_KVR), (bf16*)(ws + WS_KR), (bf16*)(ws + WS_KS), (bf16*)(ws + WS_VS), (bf16*)(ws + WS_QS), (bf16*)(ws + WS_G),
                    (float*)(ws + WS_SSQ_Q), (float*)(ws + WS_SSQ_KV), args.in[I_BGATE], (const float2*)(ws + WS_ROPE_S), (const float2*)(ws + WS_ROPE_M)};
        pg8::gemm_phase(lds, g, S, E, TID());
    }
    }
#endif
    GRID_BAR();
    asm volatile("; PHASE_MARK 3");
#if (!defined(ONLY) || ONLY == 3) && !defined(NO3A)
    for (int rep_ = 0; rep_ < REPS(3); ++rep_) { if (rep_) GRID_BAR();
    {
        pg8::Gemm g{(const bf16*)(ws + WS_QA), (const bf16*)(ws + WS_WQ), 256, 256, 256}; pg8::Order<1> S{3, G, bx};
        EpiQUp E{(bf16*)(ws + WS_QN), (bf16*)(ws + WS_QR), (const float*)(ws + WS_SSQ_Q), (const float2*)(ws + WS_ROPE_M)};
        pg8::gemm_phase(lds, g, S, E, TID());
    }
    }
#endif
#if (!defined(ONLY) || ONLY == 3) && !defined(NO3B)
    for (int rep_ = 0; rep_ < REPS(3); ++rep_) { if (rep_) GRID_BAR();
    {
        pg8::Gemm g{(const bf16*)(ws + WS_KVR), (const bf16*)(ws + WS_WKV), 256, 256, 256}; pg8::Order<0> S{4, G, bx};
        EpiKVUp E{(bf16*)(ws + WS_KN), (bf16*)(ws + WS_VM), (const float*)(ws + WS_SSQ_KV)};
        pg8::gemm_phase(lds, g, S, E, TID());
    }
    }
#endif
    GRID_BAR();
    asm volatile("; PHASE_MARK 4");
#if !defined(ONLY) || ONLY == 4
    for (int rep_ = 0; rep_ < REPS(4); ++rep_) { if (rep_) GRID_BAR();
    p4_attention(args, (char*)lds_raw, vcu, TID());
    }
#endif
    GRID_BAR();
    asm volatile("; PHASE_MARK 5");
#if !defined(ONLY) || ONLY == 5
    for (int rep_ = 0; rep_ < REPS(5); ++rep_) { if (rep_) GRID_BAR();
    {
        pg8::Gemm g{H, (const bf16*)(ws + WS_WOAB), 1024, 1024, 1024}; pg8::Order<1> S{4, G, bx};
        EpiMerge E{(bf16*)(ws + WS_M1b), (const bf16*)(ws + WS_G)};
        pg8::gemm_phase(lds, g, S, E, TID());
    }
    }
#endif
    GRID_BAR();
    asm volatile("; PHASE_MARK 6");
#if !defined(ONLY) || ONLY == 6
    for (int rep_ = 0; rep_ < REPS(6); ++rep_) { if (rep_) GRID_BAR();
    {
        pg8::Gemm g{(const bf16*)(ws + WS_M1b), (const bf16*)(ws + WS_WOUT), 1024, 1024, 1024}; pg8::Order<1> S{4, G, bx};
        EpiOutSsq E{(bf16*)(ws + WS_AL), (float*)(ws + WS_SSQ_16)};
        pg8::gemm_phase(lds, g, S, E, TID());
    }
    }
#endif
#ifdef XP6
    {
        pg8::Gemm g{(const bf16*)(ws + WS_M1b), (const bf16*)(ws + WS_WOUT), 1024, 1024, 1024}; pg8::Order<1> S{4, G, bx};
#if XP6 == 2
        EpiNull E{(float*)(ws + WS_F)};
#else
        EpiOutSsq E{(bf16*)(ws + WS_F), (float*)(ws + WS_F) + 20 * 1024 * 1024};
#endif
        pg8::gemm_phase(lds, g, S, E, TID());
    }
#endif
    GRID_BAR();
    asm volatile("; PHASE_MARK 7");
#if !defined(ONLY) || ONLY == 7
    for (int rep_ = 0; rep_ < REPS(7); ++rep_) { if (rep_) GRID_BAR();
    { int tid = TID(); asm volatile("" : "+v"(tid)); const int lane = tid & 63, wave = __builtin_amdgcn_readfirstlane(tid >> 6); p7_resid_norm(args, lds, vcu, G, tid, lane, wave); }
    }
#endif
    GRID_BAR();
    asm volatile("; PHASE_MARK 8");
#if !defined(ONLY) || ONLY == 8
    for (int rep_ = 0; rep_ < REPS(8); ++rep_) { if (rep_) GRID_BAR();
    {
        pg8::Gemm g{H, (const bf16*)(ws + WS_WUP), 1024, 1024, 1024}; pg8::Order<1> S{22, G, bx};
        EpiUp E{(bf16*)(ws + WS_ACT), (float*)(ws + WS_SB), args.in[I_CONVW], args.in[I_CONVB]};
        pg8::gemm_phase(lds, g, S, E, TID());
    }
    }
#endif
    GRID_BAR();
    asm volatile("; PHASE_MARK 9");
#if !defined(ONLY) || ONLY == 9
    for (int rep_ = 0; rep_ < REPS(9); ++rep_) { if (rep_) GRID_BAR();
    { int tid = TID(); asm volatile("" : "+v"(tid)); const int lane = tid & 63, wave = __builtin_amdgcn_readfirstlane(tid >> 6); p9_conv_fix(args, vcu, G, lane, wave); }
    }
#endif
    GRID_BAR();
    asm volatile("; PHASE_MARK 10");
#if !defined(ONLY) || ONLY == 10
    for (int rep_ = 0; rep_ < REPS(10); ++rep_) { if (rep_) GRID_BAR();
    {
        pg8::Gemm g{(const bf16*)(ws + WS_ACT), (const bf16*)(ws + WS_WDN), DFF, DFF, DFF}; pg8::Order<1> S{4, G, bx};
        EpiOutSsq E{(bf16*)(ws + WS_F), (float*)(ws + WS_SSQ_16)};
        pg8::gemm_phase(lds, g, S, E, TID());
    }
    }
#endif
    GRID_BAR();
    asm volatile("; PHASE_MARK 11");
#ifdef DEBUG_FFN
    { int tid = TID(); asm volatile("" : "+v"(tid)); const int lane = tid & 63, wave = __builtin_amdgcn_readfirstlane(tid >> 6); dbg_check_act(args, vcu, G, lane, wave); }
    GRID_BAR();
#endif
#if !defined(ONLY) || ONLY == 11
    for (int rep_ = 0; rep_ < REPS(11); ++rep_) { if (rep_) GRID_BAR();
    { int tid = TID(); asm volatile("" : "+v"(tid)); const int lane = tid & 63, wave = __builtin_amdgcn_readfirstlane(tid >> 6); p11_final(args, lds, vcu, G, tid, lane, wave); }
    }
#endif
#ifdef DEBUG_FFN
    if (bx == 0 && TID() == 0) { unsigned* ctl = (unsigned*)(ws + WS_CTL); const unsigned mask = __hip_atomic_load(ctl + DBG_W, __ATOMIC_RELAXED, __HIP_MEMORY_SCOPE_AGENT), md = __hip_atomic_load(ctl + DBG_W + 1, __ATOMIC_RELAXED, __HIP_MEMORY_SCOPE_AGENT);
        float mant = 10.f + fminf(89.f, (float)md * 0.01f); float v = mant; for (unsigned i = 0; i < 4 + mask; ++i) v *= 10.f; args.out[0] = v; }
#endif
}

extern "C" void kernel_launch(void* const* d_in, const int* in_sizes, int n_in, void* d_out, int out_size, void* d_ws, size_t ws_size, hipStream_t stream) {
    static int grid = 0;
    if (grid == 0) {
        if (n_in != 24 || out_size != RL * DM || ws_size < 452 * MiB) { fprintf(stderr, "kernel_launch: unexpected shapes (n_in %d out %d ws %zu)\n", n_in, out_size, ws_size); grid = -1; return; }
        int dev = 0, cus = 0;
        if (hipGetDevice(&dev) != hipSuccess || hipDeviceGetAttribute(&cus, hipDeviceAttributeMultiprocessorCount, dev) != hipSuccess) { grid = -1; return; }
        if (hipFuncSetAttribute((const void*)fwd_kernel, hipFuncAttributeMaxDynamicSharedMemorySize, LDS_BYTES) != hipSuccess) { fprintf(stderr, "kernel_launch: hipFuncSetAttribute failed\n"); grid = -1; return; }
        int per_cu = 0;
        if (hipOccupancyMaxActiveBlocksPerMultiprocessor(&per_cu, (const void*)fwd_kernel, NWAVES * 64, LDS_BYTES) != hipSuccess || per_cu < 1) fprintf(stderr, "kernel_launch: occupancy query says %d\n", per_cu);
        (void)hipGetLastError();
        grid = cus;
    }
    if (grid < 0) return;
    if (hipMemsetAsync((char*)d_ws + WS_CTL, 0, CTL_ZERO_BYTES, stream) != hipSuccess) return;
    Args a{};
    for (int i = 0; i < 24; ++i) a.in[i] = (const float*)d_in[i];
    a.out = (float*)d_out; a.ws = (unsigned char*)d_ws;
    hipLaunchKernelGGL(fwd_kernel, dim3(grid), dim3(NWAVES * 64), LDS_BYTES, stream, a);
}
```

```cpp
#include <hip/hip_runtime.h>
#include <hip/hip_bf16.h>
#include <cstdio>
#include <cstdint>
#include <cmath>
namespace pg8 {
#define PG8_LAS __attribute__((address_space(3)))
typedef unsigned short bf16_t;
typedef short bf16x8 __attribute__((ext_vector_type(8)));
typedef float f32x4 __attribute__((ext_vector_type(4)));
typedef unsigned u32x4 __attribute__((ext_vector_type(4)));
typedef unsigned u32x2 __attribute__((ext_vector_type(2)));
constexpr int BM = 256, BK = 64, HALF = 128, HTB = HALF * BK * 2, STAGE_BYTES = 8 * HTB, NXCD = 8, WGM = 8;

__host__ __device__ __forceinline__ int lds_byte(int r, int c) { const int st = (r >> 4) * 2 + (c >> 5), rr = r & 15, cc = c & 31, ob = rr * 64 + cc * 2; return st * 1024 + (ob ^ (((ob >> 9) & 1) << 5)); }
__host__ __device__ __forceinline__ void stage_rc(int b, int& R, int& C) { const int st = b / 1024, sb = b % 1024, swz = sb ^ (((sb >> 9) & 1) << 5); R = (st >> 1) * 16 + swz / 64; C = (st & 1) * 32 + (swz % 64) / 2; }

struct Unit { int pm, pn; };
struct Gemm { const bf16_t* A; const bf16_t* Bt; int lda, ldb, K; };

__device__ __forceinline__ bool static_unit(int nM, int nN, long L, Unit& u) {
    const int nwg = nM * nN; if (L >= nwg) return false;
    int wgid = (int)L; { const int q = nwg / NXCD, r = nwg % NXCD, xcd = wgid % NXCD, off = wgid / NXCD; wgid = (xcd < r ? xcd * (q + 1) : r * (q + 1) + (xcd - r) * q) + off; }
    const int nig = WGM * nN, gid = wgid / nig, fm = gid * WGM, gsz = (nM - fm) < WGM ? (nM - fm) : WGM;
    u.pm = fm + ((wgid % nig) % gsz); u.pn = (wgid % nig) / gsz; return true;
}
template <int MODE> struct Order {
    int nN, G, c;
    __device__ __forceinline__ bool next(int i, Unit& u) const {
        const long L = (long)i * G + c;
        if (MODE == 0) return static_unit(136, nN, L, u);
        if (MODE == 1) { if (!static_unit(128, nN, L, u)) return false; u.pm = (u.pm >> 4) * 17 + 1 + (u.pm & 15); return true; }
        if (static_unit(128, 13, L, u)) { u.pm = (u.pm >> 4) * 17 + 1 + (u.pm & 15); return true; }
        const long e = L - 128 * 13; if (e >= 16) return false;
        u.pm = (int)(e >> 1) * 17; u.pn = 1 + (int)(e & 1); return true;
    }
};

template <class Epi, class Sched>
__device__ __forceinline__ void gemm_phase(PG8_LAS unsigned char* lds, const Gemm g, const Sched& S, const Epi& E, int tid_in, int stagger_ticks = 0) {
    int tid_ = tid_in; asm volatile("" : "+v"(tid_));
    const int tid = tid_, wid = __builtin_amdgcn_readfirstlane(tid >> 6), lane = tid & 63, wr = wid >> 2, wc = wid & 3, fr = lane & 15, fq = lane >> 4;
    const int K = g.K, nt = K / BK;
    unsigned voffA[2], voffB[2];
#pragma unroll
    for (int i = 0; i < 2; ++i) { int R, C; stage_rc(tid * 16 + i * 8192, R, C);
        voffA[i] = (unsigned)(R * g.lda + C) * 2u; voffB[i] = (unsigned)(R * g.ldb + C) * 2u; }
    const size_t kstep = (size_t)(BK * 2);
    const size_t hstepA = (size_t)HALF * g.lda * 2, hstepB = (size_t)HALF * g.ldb * 2;
    const size_t tstepA = 2 * hstepA, tstepB = 2 * hstepB;
    const unsigned ldsw = (unsigned)wid * 1024u;
    const int aoff = lds_byte(wr * 64 + fr, fq * 8), boff = lds_byte(wc * 32 + fr, fq * 8);
#define PG8_SA(b, h) (((b) * 2 + (h)) * HTB)
#define PG8_SB(b, h) ((4 + (b) * 2 + (h)) * HTB)
#define PG8_STAGE(bufoff, gbase, voff) do { _Pragma("unroll") for (int _i = 0; _i < 2; ++_i) \
        __builtin_amdgcn_global_load_lds((const unsigned*)((const char*)(gbase) + (voff)[_i]), (PG8_LAS unsigned*)(lds + (bufoff) + ldsw + _i * 8192), 16, 0, 0); } while (0)
#define PG8_LDA(dst, b, h) do { _Pragma("unroll") for (int m = 0; m < 4; ++m) _Pragma("unroll") for (int k = 0; k < 2; ++k) dst[m][k] = *(const PG8_LAS bf16x8*)(lds + PG8_SA(b, h) + aoff + m * 2048 + k * 1024); } while (0)
#define PG8_LDB(dst, b, h) do { _Pragma("unroll") for (int n = 0; n < 2; ++n) _Pragma("unroll") for (int k = 0; k < 2; ++k) dst[n][k] = *(const PG8_LAS bf16x8*)(lds + PG8_SB(b, h) + boff + n * 2048 + k * 1024); } while (0)
#define PG8_MMA(ai, bj, At, Bt) do { __builtin_amdgcn_s_setprio(1); _Pragma("unroll") for (int m = 0; m < 4; ++m) _Pragma("unroll") for (int n = 0; n < 2; ++n) _Pragma("unroll") for (int k = 0; k < 2; ++k) \
        acc[ai][bj][m][n] = __builtin_amdgcn_mfma_f32_16x16x32_bf16(Bt[n][k], At[m][k], acc[ai][bj][m][n], 0, 0, 0); __builtin_amdgcn_s_setprio(0); } while (0)
#define PG8_WAIT_V(n) asm volatile("s_waitcnt vmcnt(" #n ")" ::: "memory")
#define PG8_WAIT_L(n) asm volatile("s_waitcnt lgkmcnt(" #n ")" ::: "memory")
#define PG8_BAR __builtin_amdgcn_s_barrier()
#define PG8_SCHED __builtin_amdgcn_sched_barrier(0)
    Unit cur, nxt; int ui = 0;
    if (!S.next(0, cur)) return;
    if (stagger_ticks > 0) { const unsigned long long t0_ = __builtin_amdgcn_s_memrealtime(); while (__builtin_amdgcn_s_memrealtime() - t0_ < (unsigned long long)stagger_ticks) __builtin_amdgcn_s_sleep(8); }
    f32x4 acc[2][2][4][2];
#pragma unroll
    for (int a = 0; a < 2; ++a)
#pragma unroll
        for (int b = 0; b < 2; ++b)
#pragma unroll
            for (int m = 0; m < 4; ++m)
#pragma unroll
                for (int n = 0; n < 2; ++n) acc[a][b][m][n] = (f32x4){0.f, 0.f, 0.f, 0.f};
    bf16x8 At[4][2], B0[2][2], B1[2][2];
    const char* cA = (const char*)g.A + (size_t)cur.pm * tstepA; const char* cB = (const char*)g.Bt + (size_t)cur.pn * tstepB;
    PG8_STAGE(PG8_SB(0, 0), cB, voffB); PG8_STAGE(PG8_SB(0, 1), cB + hstepB, voffB); PG8_STAGE(PG8_SA(0, 0), cA, voffA); PG8_STAGE(PG8_SA(0, 1), cA + hstepA, voffA);
    if (wr == 1) PG8_BAR;
    PG8_WAIT_V(2); PG8_BAR;
    PG8_STAGE(PG8_SB(1, 0), cB + kstep, voffB); PG8_STAGE(PG8_SA(1, 0), cA + kstep, voffA); PG8_STAGE(PG8_SB(1, 1), cB + hstepB + kstep, voffB);
    PG8_WAIT_V(6); PG8_BAR;
    for (;;) {
        const bool has_next = S.next(ui + 1, nxt);
        const char* nA = has_next ? (const char*)g.A + (size_t)nxt.pm * tstepA : cA; const char* nB = has_next ? (const char*)g.Bt + (size_t)nxt.pn * tstepB : cB;
        for (int t = 0; t < nt; t += 2) {
            if constexpr (Epi::MID_T > 0) { if (t == Epi::MID_T) { int fr_ = fr, fq_ = fq; asm volatile("" : "+v"(fr_), "+v"(fq_)); E.mid(acc, cur, wr, wc, fr_, fq_); } }
            const bool last = (t == nt - 2);
            const char* a1 = cA + (size_t)(t + 1) * kstep;
            const char* a2 = last ? nA : cA + (size_t)(t + 2) * kstep; const char* b2 = last ? nB : cB + (size_t)(t + 2) * kstep;
            const char* a3 = a2 + kstep; const char* b3 = b2 + kstep;
            PG8_LDB(B0, 0, 0); PG8_LDB(B1, 0, 1); PG8_SCHED; PG8_LDA(At, 0, 0); PG8_STAGE(PG8_SA(1, 1), a1 + hstepA, voffA);
            PG8_WAIT_V(8); PG8_WAIT_L(0); PG8_BAR; PG8_MMA(0, 0, At, B0); PG8_MMA(0, 1, At, B1); PG8_BAR; PG8_SCHED;
            PG8_LDA(At, 0, 1); PG8_STAGE(PG8_SB(0, 0), b2, voffB); PG8_STAGE(PG8_SB(0, 1), b2 + hstepB, voffB); PG8_STAGE(PG8_SA(0, 0), a2, voffA);
            PG8_WAIT_V(8); PG8_WAIT_L(0); PG8_BAR; PG8_MMA(1, 0, At, B0); PG8_MMA(1, 1, At, B1); PG8_BAR; PG8_SCHED;
            PG8_LDB(B0, 1, 0); PG8_LDB(B1, 1, 1); PG8_SCHED; PG8_LDA(At, 1, 0); PG8_STAGE(PG8_SA(0, 1), a2 + hstepA, voffA);
            PG8_WAIT_V(8); PG8_WAIT_L(0); PG8_BAR; PG8_MMA(0, 0, At, B0); PG8_MMA(0, 1, At, B1); PG8_BAR; PG8_SCHED;
            PG8_LDA(At, 1, 1); PG8_STAGE(PG8_SB(1, 0), b3, voffB); PG8_STAGE(PG8_SB(1, 1), b3 + hstepB, voffB); PG8_STAGE(PG8_SA(1, 0), a3, voffA);
            PG8_WAIT_V(8); PG8_WAIT_L(0); PG8_BAR; PG8_MMA(1, 0, At, B0); PG8_MMA(1, 1, At, B1); PG8_BAR; PG8_SCHED;
        }
        if (wr == 0) PG8_BAR;
        { int fr_ = fr, fq_ = fq; asm volatile("" : "+v"(fr_), "+v"(fq_));
          E(acc, cur, wr, wc, fr_, fq_); }
        if (!has_next) break;
#pragma unroll
        for (int a = 0; a < 2; ++a)
#pragma unroll
            for (int b = 0; b < 2; ++b)
#pragma unroll
                for (int m = 0; m < 4; ++m)
#pragma unroll
                    for (int n = 0; n < 2; ++n) acc[a][b][m][n] = (f32x4){0.f, 0.f, 0.f, 0.f};
        cur = nxt; cA = nA; cB = nB; ++ui;
        if (wr == 1) PG8_BAR;
    }
    PG8_WAIT_V(0);
    PG8_BAR;
#undef PG8_SA
#undef PG8_SB
#undef PG8_STAGE
#undef PG8_LDA
#undef PG8_LDB
#undef PG8_MMA
#undef PG8_WAIT_V
#undef PG8_WAIT_L
#undef PG8_BAR
#undef PG8_SCHED
}
}
namespace att {
typedef unsigned short bf16_t;
using bf16x8 = __attribute__((ext_vector_type(8))) short;
using s16x4  = __attribute__((ext_vector_type(4))) short;
using f32x16 = __attribute__((ext_vector_type(16))) float;
using u32x4  = __attribute__((ext_vector_type(4))) unsigned;
constexpr int NW = 8, QBLK = 32, KVBLK = 64;
constexpr int SHM_V = 64 * 64 * 2, SHM_K = 64 * 128 * 2, NVB = 4, NKB = 3;
constexpr int OFF_V = 0, OFF_K = NVB * SHM_V, OFF_WS = OFF_K + NKB * SHM_K, OFF_OST = OFF_WS + NW * 64 * 4, ATT_LDS = OFF_OST + NW * 4096;
#define KSWZ(row, colB) ((row) * 256 + ((colB) ^ (((row) & 7) << 4)))
#define SBAR() __builtin_amdgcn_sched_barrier(0)
__device__ __forceinline__ int crow(int r, int hi) { return (r & 3) + 8 * (r >> 2) + 4 * hi; }
typedef float f32x2_t __attribute__((ext_vector_type(2))); typedef __bf16 bf16x2_t __attribute__((ext_vector_type(2)));
__device__ __forceinline__ unsigned cvtpk(float lo, float hi) { f32x2_t v = {lo, hi}; bf16x2_t b = __builtin_convertvector(v, bf16x2_t); return __builtin_bit_cast(unsigned, b); }

template <int SC1000000  > struct Dummy {};

template <int VAR> __device__ __forceinline__ void partialSM(f32x16& p0, f32x16& p1, float& m_reg, float& mn, float& alpha, const float C, const float THRS) {
  float pmax = p0[0];
#pragma unroll
  for (int r = 1; r < 16; ++r) pmax = fmaxf(pmax, p0[r]);
#pragma unroll
  for (int r = 0; r < 16; ++r) pmax = fmaxf(pmax, p1[r]);
  { auto rr = __builtin_amdgcn_permlane32_swap(__float_as_uint(pmax), __float_as_uint(pmax), false, false);
    pmax = fmaxf(__uint_as_float(rr[0]), __uint_as_float(rr[1])); }
  if (__builtin_expect(__all(pmax - m_reg <= THRS), 1)) { mn = m_reg; alpha = 1.f; }
  else { mn = fmaxf(m_reg, pmax); alpha = __builtin_amdgcn_exp2f((m_reg - mn) * C); m_reg = mn; }
  float mnC = -mn * C;
#pragma unroll
  for (int r = 0; r < 16; ++r) p0[r] = fmaf(p0[r], C, mnC);
#pragma unroll
  for (int r = 0; r < 16; ++r) p1[r] = fmaf(p1[r], C, mnC);
#pragma unroll
  for (int r = 0; r < 16; ++r) p0[r] = (VAR & 1) ? p0[r] * 0.001f : __builtin_amdgcn_exp2f(p0[r]);
}
template <int VAR> __device__ __forceinline__ void finishSM(f32x16& p0, f32x16& p1, float alpha, float& l_reg, bf16x8& pa0, bf16x8& pa1, bf16x8& pa2, bf16x8& pa3) {
#pragma unroll
  for (int r = 0; r < 16; ++r) p1[r] = (VAR & 1) ? p1[r] * 0.001f : __builtin_amdgcn_exp2f(p1[r]);
  float ps = 0;
#pragma unroll
  for (int r = 0; r < 16; ++r) ps += p0[r];
#pragma unroll
  for (int r = 0; r < 16; ++r) ps += p1[r];
  { auto rr = __builtin_amdgcn_permlane32_swap(__float_as_uint(ps), __float_as_uint(ps), false, false);
    ps = __uint_as_float(rr[0]) + __uint_as_float(rr[1]); }
  l_reg = l_reg * alpha + ps;
#define PK4(P, BASE, OUT) do { unsigned a0 = cvtpk(P[BASE + 0], P[BASE + 1]), a1 = cvtpk(P[BASE + 2], P[BASE + 3]);   \
    unsigned b0 = cvtpk(P[BASE + 4], P[BASE + 5]), b1 = cvtpk(P[BASE + 6], P[BASE + 7]);                              \
    auto r0 = __builtin_amdgcn_permlane32_swap(a0, b0, false, false); auto r1 = __builtin_amdgcn_permlane32_swap(a1, b1, false, false); \
    u32x4 w = {r0[0], r1[0], r0[1], r1[1]}; OUT = *reinterpret_cast<bf16x8*>(&w); } while (0)
  PK4(p0, 0, pa0); PK4(p0, 8, pa1); PK4(p1, 0, pa2); PK4(p1, 8, pa3);
#undef PK4
}
template <int ND0, int VAR = 0> __device__ __forceinline__ void qkt(f32x16& p0, f32x16& p1, const char* Ks, const bf16x8* qr, int r32, int hi, const f32x16& negm) {
  p0 = negm; p1 = negm;
#pragma unroll
  for (int d0 = 0; d0 < ND0; ++d0) { int cb = (d0 * 16 + hi * 8) * 2;
    bf16x8 b0, b1;
    if (VAR & 4) { b0 = qr[d0]; b1 = qr[(d0 + 1) % ND0]; } else {
    b0 = *reinterpret_cast<const bf16x8*>(Ks + KSWZ(r32, cb));
    b1 = *reinterpret_cast<const bf16x8*>(Ks + KSWZ(32 + r32, cb)); }
    if (VAR & 16) { p0[d0] += (float)b0[0]; p1[d0] += (float)b1[1]; } else {
    p0 = __builtin_amdgcn_mfma_f32_32x32x16_bf16(b0, qr[d0], p0, 0, 0, 0);
    p1 = __builtin_amdgcn_mfma_f32_32x32x16_bf16(b1, qr[d0], p1, 0, 0, 0); } }
}
__device__ __forceinline__ int v_st(int k, int c) { const int kk = (k & ~0xC) | ((k & 4) << 1) | ((k & 8) >> 1); return ((kk >> 3) * 2 + (c >> 5)) * 512 + ((kk & 7) * 32 + (c & 31)) * 2; }
__device__ __forceinline__ int v_rd_base(int lane) { return ((lane & 3) << 3) | (((lane >> 2) & 3) << 6) | (((lane >> 4) & 1) << 5) | (((lane >> 5) & 1) << 8); }
constexpr int v_rd_off(int d0, int ks, int half) { return d0 * 512 + ks * 2048 + half * 1024; }
template <int OFF> __device__ __forceinline__ s16x4 tr_read(int vb) {
  s16x4 r; asm volatile("ds_read_b64_tr_b16 %0, %1 offset:%2" : "=&v"(r) : "v"(vb), "i"(OFF) : "memory"); return r;
}
template <int D0, int VAR = 0> __device__ __forceinline__ void pv_one(f32x16& od, int vb, bf16x8 pa0, bf16x8 pa1, bf16x8 pa2, bf16x8 pa3) {
  if (VAR & 8) {
    if (VAR & 16) { od[0] += (float)pa0[0]; od[1] += (float)pa1[0]; od[2] += (float)pa2[0]; od[3] += (float)pa3[0]; return; }
    od = __builtin_amdgcn_mfma_f32_32x32x16_bf16(pa0, pa1, od, 0, 0, 0); od = __builtin_amdgcn_mfma_f32_32x32x16_bf16(pa1, pa2, od, 0, 0, 0);
    od = __builtin_amdgcn_mfma_f32_32x32x16_bf16(pa2, pa3, od, 0, 0, 0); od = __builtin_amdgcn_mfma_f32_32x32x16_bf16(pa3, pa0, od, 0, 0, 0); return; }
  const s16x4 l0 = tr_read<v_rd_off(D0, 0, 0)>(vb), h0 = tr_read<v_rd_off(D0, 0, 1)>(vb), l1 = tr_read<v_rd_off(D0, 1, 0)>(vb), h1 = tr_read<v_rd_off(D0, 1, 1)>(vb);
  const s16x4 l2 = tr_read<v_rd_off(D0, 2, 0)>(vb), h2 = tr_read<v_rd_off(D0, 2, 1)>(vb), l3 = tr_read<v_rd_off(D0, 3, 0)>(vb), h3 = tr_read<v_rd_off(D0, 3, 1)>(vb);
  asm volatile("s_waitcnt lgkmcnt(0)" ::: "memory"); SBAR();
#define PK(L, H) (bf16x8){L[0], L[1], L[2], L[3], H[0], H[1], H[2], H[3]}
  od = __builtin_amdgcn_mfma_f32_32x32x16_bf16(pa0, PK(l0, h0), od, 0, 0, 0);
  od = __builtin_amdgcn_mfma_f32_32x32x16_bf16(pa1, PK(l1, h1), od, 0, 0, 0);
  od = __builtin_amdgcn_mfma_f32_32x32x16_bf16(pa2, PK(l2, h2), od, 0, 0, 0);
  od = __builtin_amdgcn_mfma_f32_32x32x16_bf16(pa3, PK(l3, h3), od, 0, 0, 0);
#undef PK
}
template <int VAR = 0> __device__ __forceinline__ void pv_d0(f32x16* o, int vb, bf16x8 pa0, bf16x8 pa1, bf16x8 pa2, bf16x8 pa3) {
  pv_one<0, VAR>(o[0], vb, pa0, pa1, pa2, pa3); pv_one<1, VAR>(o[1], vb, pa0, pa1, pa2, pa3);
}

struct AttnIO {
  const bf16_t* Q1;
  const bf16_t* Q2;
  const bf16_t* K1;
  const bf16_t* K2;
  const bf16_t* V;
  bf16_t* O;
};
template <bool SWA, int VAR = 0>
__device__ __forceinline__ void attn_unit(const AttnIO io, const int q0  , const float sink, char* lds, int tid_in) {
  constexpr int ND0 = SWA ? 4 : 6;
  constexpr int LDQ1 = 512, LDQ2 = 256, LDK1 = SWA ? 128 : 512, LDK2 = 32, LDV = SWA ? 128 : 512, LDO = 1024;
  constexpr float SCALE = SWA ? 0.125f : 0.10206207261596575f;
  int tid_ = tid_in; asm volatile("" : "+v"(tid_));
  const int tid = tid_, wid = tid >> 6, lane = tid & 63, r32 = lane & 31, hi = lane >> 5;
  char* V_lds = lds + OFF_V; char* K_lds = lds + OFF_K;
  float* ws = (float*)(lds + OFF_WS) + wid * 64; float* li_l = ws; float* al_l = ws + 32;
  float l_reg = 0; f32x16 o[2] = {}; bf16x8 qr[ND0];
  {
    const bf16_t* Qw = io.Q1 + (long)(wid * QBLK + r32) * LDQ1 + hi * 8;
#pragma unroll
    for (int d0 = 0; d0 < 4; ++d0) qr[d0] = *reinterpret_cast<const bf16x8*>(Qw + d0 * 16);
    if constexpr (!SWA) {
      const bf16_t* Qw2 = io.Q2 + (long)(wid * QBLK + r32) * LDQ2 + hi * 8;
#pragma unroll
      for (int d0 = 0; d0 < 2; ++d0) qr[4 + d0] = *reinterpret_cast<const bf16x8*>(Qw2 + d0 * 16);
    }
  }
  const int sr = tid >> 3, sc = (tid & 7) * 8, vst = v_st(sr, sc), kst = KSWZ(sr, sc * 2);
  const int sr2 = (tid & 255) >> 2, sc2 = (tid & 3) * 8, kst2 = KSWZ(sr2, (64 + sc2) * 2);
  const int vb0 = (int)(uintptr_t)V_lds + v_rd_base(lane);
  int NT, jlo = 0;
  if constexpr (SWA) { jlo = (q0 == 0) ? 2 : 0; NT = 4 + 8 - jlo - ((q0 == 4096 - 256) ? 2 : 0); } else NT = 68;
#define KEY0(t) (SWA ? ((t) < 4 ? (t) * 64 : 256 + q0 - 128 + ((t) - 4 + jlo) * 64) : (t) * 64)
  struct { bf16x8 v, k, k2; } sr_;
#define SLOAD(t) do { if (VAR & 2) break; const long k0_ = KEY0(t); sr_.v = *reinterpret_cast<const bf16x8*>(io.V + (k0_ + sr) * LDV + sc); \
    sr_.k = *reinterpret_cast<const bf16x8*>(io.K1 + (k0_ + sr) * LDK1 + sc); \
    if constexpr (!SWA) sr_.k2 = *reinterpret_cast<const bf16x8*>(io.K2 + (k0_ + sr2) * LDK2 + sc2); } while (0)
#define SWRITE(kb_, vb_) do { if (VAR & 2) break; *(bf16x8*)(V_lds + (vb_) * SHM_V + vst) = sr_.v; *(bf16x8*)(K_lds + (kb_) * SHM_K + kst) = sr_.k; \
    if constexpr (!SWA) { if (tid < 256) *(bf16x8*)(K_lds + (kb_) * SHM_K + kst2) = sr_.k2; } } while (0)
#define RESC(a) do { if (__any((a) < 1.f)) { if (hi == 0) al_l[r32] = (a); asm volatile("s_waitcnt lgkmcnt(0)" ::: "memory"); \
    _Pragma("unroll") for (int d = 0; d < 2; ++d) _Pragma("unroll") for (int r = 0; r < 16; ++r) o[d][r] *= al_l[crow(r, hi)]; } } while (0)
#define MASK(P0, P1, t) do { if constexpr (SWA) { if ((t) >= 4) { const int base_ = -128 + ((t) - 4 + jlo) * 64 - wid * QBLK - r32 + 4 * hi; \
    _Pragma("unroll") for (int r = 0; r < 16; ++r) { const int d_ = base_ + (r & 3) + 8 * (r >> 2); \
      if (d_ > 128 || d_ < -128) P0[r] = -INFINITY; if (d_ + 32 > 128 || d_ + 32 < -128) P1[r] = -INFINITY; } } } } while (0)
  f32x16 p0, p1; float al; bf16x8 pa0, pa1, pa2, pa3;
  const int half = __builtin_amdgcn_readfirstlane(wid >> 2);
  f32x16 negm = f32x16{}; asm volatile("" : "+v"(negm));
  float mref = 0.f; constexpr float THR2 = 8.f;
#define SOFTMAX(t, FIRST) do { MASK(p0, p1, t); \
    float pmax_ = p0[0]; _Pragma("unroll") for (int r = 1; r < 16; ++r) pmax_ = fmaxf(pmax_, p0[r]); _Pragma("unroll") for (int r = 0; r < 16; ++r) pmax_ = fmaxf(pmax_, p1[r]); \
    { auto rr = __builtin_amdgcn_permlane32_swap(__float_as_uint(pmax_), __float_as_uint(pmax_), false, false); pmax_ = fmaxf(__uint_as_float(rr[0]), __uint_as_float(rr[1])); } \
    al = 1.f; \
    if ((FIRST) || !__all(pmax_ <= THR2)) { const float dl_ = (FIRST) ? pmax_ : fmaxf(pmax_, 0.f); mref += dl_; al = (FIRST) ? 1.f : __builtin_amdgcn_exp2f(-dl_); \
      _Pragma("unroll") for (int r = 0; r < 16; ++r) { p0[r] -= dl_; p1[r] -= dl_; } \
      _Pragma("unroll") for (int r = 0; r < 16; ++r) negm[r] = -mref; asm volatile("" : "+v"(negm)); \
      if (!(FIRST)) RESC(al); } \
    _Pragma("unroll") for (int r = 0; r < 16; ++r) p0[r] = (VAR & 1) ? p0[r] * 0.001f : __builtin_amdgcn_exp2f(p0[r]); \
    finishSM<VAR>(p0, p1, al, l_reg, pa0, pa1, pa2, pa3); } while (0)
  typedef __attribute__((address_space(3))) const char* lcp; typedef short v4i16_t __attribute__((ext_vector_type(4)));
  const lcp K3 = (lcp)K_lds; const lcp V3 = (lcp)V_lds + v_rd_base(lane);
  bf16x8 kf[2 * ND0]; s16x4 vlo[8], vhi[8];
#define LDK(kb_) do { _Pragma("unroll") for (int d0 = 0; d0 < ND0; ++d0) { const int cb = (d0 * 16 + hi * 8) * 2; \
    kf[2 * d0] = *(const __attribute__((address_space(3))) bf16x8*)(K3 + (kb_) * SHM_K + KSWZ(r32, cb)); \
    kf[2 * d0 + 1] = *(const __attribute__((address_space(3))) bf16x8*)(K3 + (kb_) * SHM_K + KSWZ(32 + r32, cb)); } } while (0)
#define VTR(p_) __builtin_bit_cast(s16x4, __builtin_amdgcn_ds_read_tr16_b64_v4i16((__attribute__((address_space(3))) v4i16_t*)(p_)))
#define LDV(vb_) do { _Pragma("unroll") for (int d0 = 0; d0 < 2; ++d0) _Pragma("unroll") for (int ks = 0; ks < 4; ++ks) { \
    vlo[d0 * 4 + ks] = VTR(V3 + (vb_) * SHM_V + v_rd_off(d0, ks, 0)); vhi[d0 * 4 + ks] = VTR(V3 + (vb_) * SHM_V + v_rd_off(d0, ks, 1)); } } while (0)
#define VFR(i) (bf16x8){vlo[i][0], vlo[i][1], vlo[i][2], vlo[i][3], vhi[i][0], vhi[i][1], vhi[i][2], vhi[i][3]}
#define MM(acc, a, b) acc = __builtin_amdgcn_mfma_f32_32x32x16_bf16(a, b, acc, 0, 0, 0)
#define MSEG(DO_PV, DO_QK) do { __builtin_amdgcn_s_setprio(1); \
    if (DO_QK) { p0 = negm; p1 = negm; } \
    if (DO_QK) { MM(p0, kf[0], qr[0]); MM(p1, kf[1], qr[0]); } if (DO_PV) { MM(o[0], pa0, VFR(0)); MM(o[1], pa0, VFR(4)); } \
    if (DO_QK) { MM(p0, kf[2], qr[1]); MM(p1, kf[3], qr[1]); } if (DO_PV) { MM(o[0], pa1, VFR(1)); MM(o[1], pa1, VFR(5)); } \
    if (DO_QK) { MM(p0, kf[4], qr[2]); MM(p1, kf[5], qr[2]); } if (DO_PV) { MM(o[0], pa2, VFR(2)); MM(o[1], pa2, VFR(6)); } \
    if (DO_QK) { MM(p0, kf[6], qr[3]); MM(p1, kf[7], qr[3]); } if (DO_PV) { MM(o[0], pa3, VFR(3)); MM(o[1], pa3, VFR(7)); } \
    if constexpr (ND0 > 4) { if (DO_QK) { MM(p0, kf[8], qr[4]); MM(p1, kf[9], qr[4]); MM(p0, kf[10], qr[5]); MM(p1, kf[11], qr[5]); } } \
    __builtin_amdgcn_s_setprio(0); } while (0)
  SLOAD(0); asm volatile("s_waitcnt vmcnt(0)" ::: "memory"); SWRITE(0, 0); SLOAD(1); asm volatile("s_waitcnt vmcnt(0)" ::: "memory"); SWRITE(1, 1); if (2 < NT) SLOAD(2);
  __syncthreads();
  if (half) __syncthreads();
  int kc = 0, vp = 3;
  LDK(0); SBAR(); MSEG(false, true);
  __syncthreads();
  SOFTMAX(0, true); if (2 < NT) SWRITE(2, 2); if (3 < NT) SLOAD(3);
  __syncthreads();
  for (int t = 1; t < NT; ++t) {
    kc = (kc == NKB - 1) ? 0 : kc + 1; vp = (vp == NVB - 1) ? 0 : vp + 1;
    SBAR(); LDK(kc); LDV(vp); SBAR(); MSEG(true, true); SBAR();
    __syncthreads();
    SOFTMAX(t, false);
    if (t + 2 < NT) { int k2 = kc + 2; if (k2 >= NKB) k2 -= NKB; int v2 = vp + 3; if (v2 >= NVB) v2 -= NVB; SWRITE(k2, v2); }
    if (t + 3 < NT) SLOAD(t + 3);
    __syncthreads();
  }
  vp = (vp == NVB - 1) ? 0 : vp + 1;
  LDV(vp); SBAR(); MSEG(true, false);
  if (!half) __syncthreads();
#undef MSEG
#undef MM
#undef VFR
#undef LDV
#undef VTR
#undef LDK
#undef SOFTMAX
  if constexpr (SWA) l_reg += __builtin_amdgcn_exp2f(sink * 1.4426950408889634f - mref);
  if (hi == 0) li_l[r32] = l_reg; asm volatile("s_waitcnt lgkmcnt(0)" ::: "memory");
  float rli[16];
#pragma unroll
  for (int r = 0; r < 16; ++r) rli[r] = __builtin_amdgcn_rcpf(li_l[crow(r, hi)]);
  { bf16_t* stg = (bf16_t*)(lds + OFF_OST) + wid * 2048;
#pragma unroll
    for (int r = 0; r < 16; ++r) { const int orow = crow(r, hi);
#pragma unroll
      for (int d0 = 0; d0 < 2; ++d0) stg[orow * 64 + d0 * 32 + r32] = (bf16_t)(cvtpk(o[d0][r] * rli[r], 0.f) & 0xffffu); }
    asm volatile("s_waitcnt lgkmcnt(0)" ::: "memory");
    bf16_t* Ow = io.O + (long)(wid * QBLK) * LDO;
#pragma unroll
    for (int i = 0; i < 4; ++i) { const int row = i * 8 + (lane >> 3), ch = lane & 7; const u32x4 v = *(const u32x4*)(stg + row * 64 + ch * 8); *(u32x4*)(Ow + (long)row * LDO + ch * 8) = v; } }
  __syncthreads();
#undef SLOAD
#undef SWRITE
#undef RESC
#undef MASK
#undef KEY0
}
#undef KSWZ
#undef SBAR
}
constexpr int NWAVES = 8;
constexpr int DM = 1024, NB = 8, SEQ = 4096, CTX = 256, TPB = SEQ + CTX  , RT = NB * TPB  , RL = NB * SEQ  ;
constexpr int DIN = 3232, DINP = 3328, DFF = 2816, DUP = 5632;
constexpr float EPS = 1e-6f;
constexpr size_t MiB = 1u << 20;
constexpr size_t WS_CTL = 0, CTL_ZERO_BYTES = 64 * 1024;
constexpr size_t WS_ROPE_S = 64 * 1024;
constexpr size_t WS_ROPE_M = WS_ROPE_S + 64 * 16 * 8;
constexpr size_t WS_MODF = 128 * 1024;
constexpr size_t WS_SSQ_Q = 512 * 1024;
constexpr size_t WS_SSQ_KV = WS_SSQ_Q + (size_t)RT * 16;
constexpr size_t WS_SSQ_16 = WS_SSQ_KV + (size_t)RT * 16;
constexpr size_t WS_MODP = 4 * MiB;
constexpr size_t WS_WIN = 8 * MiB;
constexpr size_t WS_WQ = WS_WIN + (size_t)DINP * 1024 * 2;
constexpr size_t WS_WKV = WS_WQ + 768 * 256 * 2;
constexpr size_t WS_WOAB = WS_WKV + 1024 * 256 * 2;
constexpr size_t WS_WOUT = WS_WOAB + 1024 * 1024 * 2;
constexpr size_t WS_WUP = WS_WOUT + 1024 * 1024 * 2;
constexpr size_t WS_WDN = WS_WUP + (size_t)DUP * 1024 * 2;
static_assert(WS_WDN + (size_t)1024 * DFF * 2 <= 40 * MiB, "weights");
constexpr size_t WS_H = 40 * MiB;
constexpr size_t WS_G = 108 * MiB;
constexpr size_t WS_QA = 244 * MiB, WS_KVR = 261 * MiB, WS_KR = 278 * MiB, WS_KS = 281 * MiB, WS_VS = 290 * MiB, WS_QS = 299 * MiB;
constexpr size_t WS_QN = 333 * MiB, WS_QR = 367 * MiB, WS_KN = 384 * MiB, WS_VM = 418 * MiB;
constexpr size_t WS_M1 = 452 * MiB;
constexpr size_t WS_END_REQ = 512 * MiB;
constexpr size_t WS_M1b = 244 * MiB;
constexpr size_t WS_AL = 312 * MiB;
constexpr size_t WS_SB = 312 * MiB;
constexpr size_t WS_F = 380 * MiB;
constexpr size_t WS_ACT = 108 * MiB;

constexpr int RING_BYTES = 131072, MISC_OFF = RING_BYTES + 320, LDS_BYTES = 147456;

#define GAS __attribute__((address_space(1)))
#define LAS __attribute__((address_space(3)))
typedef unsigned short bf16;
typedef unsigned v4u __attribute__((ext_vector_type(4)));
typedef unsigned v2u __attribute__((ext_vector_type(2)));
typedef float f32x4 __attribute__((ext_vector_type(4)));
#define LDS_WAIT() asm volatile("s_waitcnt lgkmcnt(0)" ::: "memory")
#define VM_WAIT() asm volatile("s_waitcnt vmcnt(0)" ::: "memory")
__device__ __forceinline__ unsigned pk2(float lo, float hi) { return att::cvtpk(lo, hi); }
__device__ __forceinline__ float bf2f(unsigned short b) { return __uint_as_float((unsigned)b << 16); }
__device__ __forceinline__ v2u pk4(f32x4 v) { v2u w; w.x = pk2(v[0], v[1]); w.y = pk2(v[2], v[3]); return w; }
__device__ __forceinline__ f32x4 unpk4(v2u w) { f32x4 v; v[0] = __uint_as_float(w.x << 16); v[1] = __uint_as_float(w.x & 0xffff0000u); v[2] = __uint_as_float(w.y << 16); v[3] = __uint_as_float(w.y & 0xffff0000u); return v; }

#define XB_TMO      128
#define XB_XCNT(j)  (256  + 64 * (j))
#define XB_XSUB(j)  (1280 + 64 * (j))
#define XB_XGEN(j)  (2304 + 64 * (j))
#define XB_TOP      3328
#define XB_TOPGEN   3392
#define XCD_BAR_WORDS 3456
#define XB_SPIN_CAP (1u << 22)
__device__ __forceinline__ unsigned xb_ld(unsigned* p)              { return __hip_atomic_load(p, __ATOMIC_RELAXED, __HIP_MEMORY_SCOPE_AGENT); }
__device__ __forceinline__ unsigned xb_add(unsigned* p, unsigned v) { return __hip_atomic_fetch_add(p, v, __ATOMIC_RELAXED, __HIP_MEMORY_SCOPE_AGENT); }
__device__ __forceinline__ unsigned xb_xcc_id() { return (unsigned)__builtin_amdgcn_s_getreg((3 << 11) | 20) & 0xFu; }
#define XB_SPIN(cond, bar) do { unsigned _sp = 0; while (cond) { __builtin_amdgcn_s_sleep(1); \
    if ((++_sp & 255u) == 0u) { if (xb_ld(&(bar)[XB_TMO])) break; if (_sp > XB_SPIN_CAP) { atomicAdd(&(bar)[XB_TMO], 1u); break; } } } } while (0)
struct XcdBarrier { unsigned* bar; unsigned x; volatile LAS unsigned* st; };
__device__ __forceinline__ XcdBarrier xcd_barrier_post(unsigned* bar, volatile LAS unsigned* st) {
    XcdBarrier b; b.bar = bar; b.x = xb_xcc_id(); b.st = st;
    if (threadIdx.x == 0) (void)xb_add(&bar[XB_XCNT(b.x)], 1u);
    return b;
}
__device__ __forceinline__ void xcd_barrier_complete(unsigned* bar, unsigned x, unsigned& nloc, unsigned& nx) {
    const unsigned G = gridDim.x * gridDim.y * gridDim.z;
    unsigned sum, cnt, mine, sp = 0u;
    for (;;) {
        sum = 0u; cnt = 0u; mine = 0u;
#pragma unroll
        for (unsigned j = 0; j < 16; ++j) { const unsigned c = xb_ld(&bar[XB_XCNT(j)]); sum += c; cnt += (c > 0u) ? 1u : 0u; mine = (j == x) ? c : mine; }
        if (sum == G) break;
        __builtin_amdgcn_s_sleep(1);
        if ((++sp & 255u) == 0u) { if (xb_ld(&bar[XB_TMO])) break; if (sp > XB_SPIN_CAP) { atomicAdd(&bar[XB_TMO], 1u); break; } }
    }
    nloc = mine > 0u ? mine : 1u; nx = cnt > 0u ? cnt : 1u;
}
__device__ __forceinline__ void xcd_barrier(const XcdBarrier& b) {
    asm volatile("s_waitcnt vmcnt(0)" ::: "memory");
    __syncthreads();
    if (threadIdx.x == 0) {
        unsigned* bar = b.bar;
        __builtin_amdgcn_s_waitcnt(0);
        unsigned nloc = b.st[0], nx = b.st[1];
        if (nloc == 0u) { xcd_barrier_complete(bar, b.x, nloc, nx); b.st[0] = nloc; b.st[1] = nx; }
        const unsigned old = xb_add(&bar[XB_XSUB(b.x)], 1u);
        const unsigned gen = old / nloc;
        if (old + 1u == (gen + 1u) * nloc) {
            __builtin_amdgcn_fence(__ATOMIC_RELEASE, "agent");
            asm volatile("s_waitcnt vmcnt(0)" ::: "memory");
            const unsigned og = xb_add(&bar[XB_TOP], 1u);
            const unsigned tg = og / nx;
            if (og + 1u == (tg + 1u) * nx) xb_add(&bar[XB_TOPGEN], 1u);
            else XB_SPIN(xb_ld(&bar[XB_TOPGEN]) == tg, bar);
            __builtin_amdgcn_fence(__ATOMIC_ACQUIRE, "agent");
            xb_add(&bar[XB_XGEN(b.x)], 1u);
            asm volatile("s_waitcnt vmcnt(0)" ::: "memory");
        } else {
            XB_SPIN(xb_ld(&bar[XB_XGEN(b.x)]) == gen, bar);
            __builtin_amdgcn_fence(__ATOMIC_ACQUIRE, "agent");
            asm volatile("s_waitcnt vmcnt(0)" ::: "memory");
        }
    }
    __syncthreads();
}

#if 1
#define NTL(p) __builtin_nontemporal_load(p)
#define NTS(v, p) __builtin_nontemporal_store(v, p)
#else
#define NTL(p) (*(p))
#define NTS(v, p) (*(p) = (v))
#endif
__device__ __forceinline__ float ssq4(f32x4 v) { return (v[0] * v[0] + v[1] * v[1]) + (v[2] * v[2] + v[3] * v[3]); }
__device__ __forceinline__ float wave_sum(float v) {
#pragma unroll
    for (int o = 1; o < 64; o <<= 1) v += __shfl_xor(v, o);
    return v;
}
__device__ __forceinline__ float silu_f(float v) { return v * __builtin_amdgcn_rcpf(1.f + __builtin_amdgcn_exp2f(-1.4426950408889634f * v)); }
__device__ __forceinline__ float sigmoid_f(float v) { return __builtin_amdgcn_rcpf(1.f + __builtin_amdgcn_exp2f(-1.4426950408889634f * v)); }

struct Args { const float* in[24]; float* out; unsigned char* ws; };
enum { I_X = 0, I_C, I_CTX, I_CCTX, I_WADA, I_BADA, I_APRE, I_APOST, I_WIN, I_BGATE, I_QNG, I_WQUP, I_KVNG, I_WKVUP, I_WOM, I_SINK, I_WOS, I_WOUT, I_FPRE, I_FPOST, I_WUP, I_CONVW, I_CONVB, I_WDN };
__device__ __forceinline__ void transpose_item(const float* W, int N, int k0, int n0, bf16* WT, int ldw, int drow0, int dk0, const float* gain, LAS float* scr, int lane, int perm) {
#pragma unroll 8
    for (int i = 0; i < 32; ++i) { const int kk = 2 * i + (lane >> 5); float v = W[(size_t)(k0 + kk) * N + n0 + (lane & 31)]; if (gain) v *= gain[k0 + kk]; scr[kk * 33 + (lane & 31)] = v; }
    LDS_WAIT(); asm volatile("" ::: "memory");
    const int c = lane & 7;
#pragma unroll
    for (int j = 0; j < 4; ++j) { const int n = (lane >> 3) + 8 * j; const LAS float* s = scr + (8 * c) * 33 + n;
        v4u o; o.x = pk2(s[0 * 33], s[1 * 33]); o.y = pk2(s[2 * 33], s[3 * 33]); o.z = pk2(s[4 * 33], s[5 * 33]); o.w = pk2(s[6 * 33], s[7 * 33]);
        int dr;
        if (perm == 2) { const int tb = 1280 + (((drow0 - 1280) >> 8) << 8), L = ((drow0 - 1280) & 255) + n;
                         dr = tb + 128 * ((L >> 3) & 1) + 32 * (L >> 6) + 16 * ((L >> 2) & 1) + 4 * ((L >> 4) & 3) + (L & 3); }
        else dr = drow0 + (perm ? 16 * ((n >> 2) & 1) + 4 * (n >> 3) + (n & 3) : n);
        *(GAS v4u*)(WT + (size_t)dr * ldw + dk0 + k0 + 8 * c) = o; }
    LDS_WAIT(); asm volatile("" ::: "memory");
}
__device__ __forceinline__ int inproj_row(int n) {
    if (n < 416) return n;
    if (n < 928) return n - 416 + 768;
    if (n < 1056) return n - 928 + 512;
    if (n < 1184) return n - 1056 + 640;
    return n - 1184 + 1280;
}
__device__ __forceinline__ float inv_freq16(int f) {
    switch (f) { case 0: return 1.0f; case 1: return 0.5623413324356079f; case 2: return 0.3162277638912201f; case 3: return 0.17782793939113617f; case 4: return 0.10000000149011612f;
        case 5: return 0.05623413249850273f; case 6: return 0.03162277489900589f; case 7: return 0.017782794311642647f; case 8: return 0.009999999776482582f; case 9: return 0.005623413249850273f;
        case 10: return 0.003162277629598975f; case 11: return 0.0017782794311642647f; case 12: return 0.0010000000474974513f; case 13: return 0.000562341301701963f;
        case 14: return 0.0003162277571391314f; default: return 0.00017782794020604342f; }
}
__device__ __forceinline__ void sincos_acc(float ang, float& c, float& s) {
    const double a = (double)ang;
    const double k = __builtin_rint(a * 0.63661977236758134308);
    const double r = (a - k * 1.5707963267948966192) - k * 6.123233995736766e-17;
    const double r2 = r * r;
    const double sn = r * (1.0 + r2 * (-1.0 / 6 + r2 * (1.0 / 120 + r2 * (-1.0 / 5040 + r2 * (1.0 / 362880 + r2 * (-1.0 / 39916800 + r2 * (1.0 / 6227020800.0)))))));
    const double cs = 1.0 + r2 * (-0.5 + r2 * (1.0 / 24 + r2 * (-1.0 / 720 + r2 * (1.0 / 40320 + r2 * (-1.0 / 3628800 + r2 * (1.0 / 479001600.0 + r2 * (-1.0 / 87178291200.0)))))));
    const int q = ((int)k) & 3;
    const double cc = (q == 0) ? cs : (q == 1) ? -sn : (q == 2) ? -cs : sn;
    const double ss = (q == 0) ? sn : (q == 1) ? cs : (q == 2) ? -sn : -cs;
    c = (float)cc; s = (float)ss;
}
__device__ __forceinline__ void p0_prologue(const Args& a, LAS unsigned char* lds, int vcu, int G, int tid, int lane, int wave) {
    unsigned char* ws = a.ws;
    LAS float* scr = (LAS float*)(lds + wave * 16384);
    const int gw = vcu * NWAVES + wave, NGW = G * NWAVES;
    bf16* WIN = (bf16*)(ws + WS_WIN); bf16* WQ = (bf16*)(ws + WS_WQ); bf16* WKV = (bf16*)(ws + WS_WKV); bf16* WOAB = (bf16*)(ws + WS_WOAB);
    bf16* WOUT = (bf16*)(ws + WS_WOUT); bf16* WUP = (bf16*)(ws + WS_WUP); bf16* WDN = (bf16*)(ws + WS_WDN);
    constexpr int I_IN = 16 * (DIN / 32), I_Q = 4 * 24, I_KV = 2 * 32, I_OA = 8 * 32, I_OB = 8 * 32, I_OUT = 16 * 32, I_UP = 16 * (DUP / 32), I_DN = 44 * 32;
    constexpr int NITEMS = I_IN + I_Q + I_KV + I_OA + I_OB + I_OUT + I_UP + I_DN;
    for (int it = gw; it < NITEMS; it += NGW) {
        int r = it;
        if (r < I_IN) { const int nblk = DIN / 32, kb = r / nblk, nb = r % nblk; { const int dr = inproj_row(32 * nb); const int pm_ = (dr >= 1280) ? 2 : ((dr < 384) || (dr >= 640 && dr < 768)) ? 1 : 0;
              transpose_item(a.in[I_WIN], DIN, 64 * kb, 32 * nb, WIN, 1024, dr, 0, nullptr, scr, lane, pm_); } continue; } r -= I_IN;
        if (r < I_Q) { const int kb = r / 24, nb = r % 24, n0 = 32 * nb, hd = n0 / 96, cc = n0 % 96; const int drow = cc < 64 ? hd * 64 + cc : 512 + hd * 32 + (cc - 64);
            transpose_item(a.in[I_WQUP], 768, 64 * kb, n0, WQ, 256, drow, 0, a.in[I_QNG], scr, lane, cc < 64); continue; } r -= I_Q;
        if (r < I_KV) { const int kb = r / 32, nb = r % 32, n0 = 32 * nb, hd = n0 / 128, cc = n0 % 128; const int drow = cc < 64 ? hd * 64 + cc : 512 + hd * 64 + (cc - 64);
            transpose_item(a.in[I_WKVUP], 1024, 64 * kb, n0, WKV, 256, drow, 0, a.in[I_KVNG], scr, lane, true); continue; } r -= I_KV;
        if (r < I_OA) { const int kb = r / 32, nb = r % 32; transpose_item(a.in[I_WOM], 1024, 64 * kb, 32 * nb, WOAB, 1024, 32 * nb, 0, nullptr, scr, lane, true); continue; } r -= I_OA;
        if (r < I_OB) { const int kb = r / 32, nb = r % 32; transpose_item(a.in[I_WOS], 1024, 64 * kb, 32 * nb, WOAB, 1024, 32 * nb, 512, nullptr, scr, lane, true); continue; } r -= I_OB;
        if (r < I_OUT) { const int kb = r / 32, nb = r % 32; transpose_item(a.in[I_WOUT], 1024, 64 * kb, 32 * nb, WOUT, 1024, 32 * nb, 0, nullptr, scr, lane, true); continue; } r -= I_OUT;
        if (r < I_UP) { const int nblk = DUP / 32, kb = r / nblk, nb = r % nblk, n0 = 32 * nb; const int drow = n0 < DFF ? (n0 / 128) * 256 + (n0 % 128) : ((n0 - DFF) / 128) * 256 + 128 + ((n0 - DFF) % 128);
            transpose_item(a.in[I_WUP], DUP, 64 * kb, n0, WUP, 1024, drow, 0, nullptr, scr, lane, true); continue; } r -= I_UP;
        { const int kb = r / 32, nb = r % 32; transpose_item(a.in[I_WDN], 1024, 64 * kb, 32 * nb, WDN, DFF, 32 * nb, 0, nullptr, scr, lane, true); }
    }
    { const int gt = vcu * 512 + tid, NTH = G * 512;
      for (int i = gt; i < 96 * 128; i += NTH) *(GAS v4u*)(WIN + (size_t)(416 + i / 128) * 1024 + (i % 128) * 8) = (v4u){0u, 0u, 0u, 0u};
      for (int i = gt; i < 1024 * 16; i += NTH) *(GAS v4u*)(WKV + (size_t)(i / 16) * 256 + 128 + (i % 16) * 8) = (v4u){0u, 0u, 0u, 0u};
      float2* RS = (float2*)(ws + WS_ROPE_S); float2* RM = (float2*)(ws + WS_ROPE_M);
      for (int i = gt; i < 64 * 16 + 64 * 8; i += NTH) {
          const bool sw = i < 64 * 16; const int j = sw ? i : i - 64 * 16; const int pos = sw ? j / 16 : j / 8, f = sw ? j % 16 : j % 8;
          const int f16 = sw ? f : 2 * f;
          const float inv = inv_freq16(f16);
          const float ang = (float)pos * inv; float c, s; sincos_acc(ang, c, s);
          if (sw) RS[j] = make_float2(c, s); else RM[j] = make_float2(c, s);
      }
    }
    { LAS float* sv = (LAS float*)(lds + wave * 16384 + 12288);
      float* MODP = (float*)(ws + WS_MODP); const float* wada = a.in[I_WADA];
      for (int task = gw; task < 96 * 16; task += NGW) {
          const int cg = task % 96, ks = task / 96, col = cg * 64 + lane, kk0 = ks * 64;
#pragma unroll
          for (int b = 0; b < 9; ++b) { const float cv = (b < 8) ? a.in[I_C][b * 1024 + kk0 + lane] : a.in[I_CCTX][kk0 + lane]; sv[b * 64 + lane] = silu_f(cv); }
          LDS_WAIT(); asm volatile("" ::: "memory");
          float acc[9];
#pragma unroll
          for (int b = 0; b < 9; ++b) acc[b] = 0.f;
#pragma unroll 8
          for (int k = 0; k < 64; ++k) { const float w = wada[(size_t)(kk0 + k) * 6144 + col];
#pragma unroll
              for (int b = 0; b < 9; ++b) acc[b] = fmaf(sv[b * 64 + k], w, acc[b]); }
#pragma unroll
          for (int b = 0; b < 9; ++b) MODP[(size_t)(ks * 9 + b) * 6144 + col] = acc[b];
          LDS_WAIT(); asm volatile("" ::: "memory");
      }
    }
}
__device__ __forceinline__ float mod_from_partials(const float* MODP, const float* bada, int b, int j) {
    float s = bada[j];
#pragma unroll
    for (int ks = 0; ks < 16; ++ks) s += MODP[(size_t)(ks * 9 + b) * 6144 + j];
    return s;
}

__device__ __forceinline__ void p1_norm_mod(const Args& a, LAS unsigned char* lds, int vcu, int G, int tid, int lane, int wave) {
    unsigned char* ws = a.ws; const float* MODP = (const float*)(ws + WS_MODP); float* MODF = (float*)(ws + WS_MODF);
    for (int i = vcu * 512 + tid; i < 9 * 6144; i += G * 512) MODF[i] = mod_from_partials(MODP, a.in[I_BADA], i / 6144, i % 6144);
    LAS float* msh = (LAS float*)lds;
    LAS float* msc = msh + 1024;
    LAS float* mg = msc + 1024;
    bf16* H = (bf16*)(ws + WS_H);
    const int rows_per = (RT + G - 1) / G;
    int r = vcu * rows_per; const int rend = (r + rows_per < RT) ? r + rows_per : RT;
    while (r < rend) {
        const int b = r / TPB, t = r % TPB; const bool ctx = t < CTX; const int seg_end = b * TPB + (ctx ? CTX : TPB); const int e = seg_end < rend ? seg_end : rend;
        const int mb = ctx ? 8 : b;
        __syncthreads();
        for (int j = tid; j < 1024; j += 512) { msh[j] = mod_from_partials(MODP, a.in[I_BADA], mb, j); msc[j] = 1.f + mod_from_partials(MODP, a.in[I_BADA], mb, 1024 + j); mg[j] = a.in[I_APRE][j]; }
        __syncthreads();
        for (int row0 = r + 2 * wave; row0 < e; row0 += 2 * NWAVES) {
            const bool two = row0 + 1 < e; const int row1 = two ? row0 + 1 : row0;
            const int t0 = row0 - b * TPB, t1 = row1 - b * TPB;
            const float* src0 = ctx ? a.in[I_CTX] + (size_t)(b * CTX + t0) * 1024 : a.in[I_X] + (size_t)(b * SEQ + t0 - CTX) * 1024;
            const float* src1 = ctx ? a.in[I_CTX] + (size_t)(b * CTX + t1) * 1024 : a.in[I_X] + (size_t)(b * SEQ + t1 - CTX) * 1024;
            const GAS f32x4* xr0 = (const GAS f32x4*)src0 + lane; const GAS f32x4* xr1 = (const GAS f32x4*)src1 + lane;
            f32x4 v0[4], v1[4]; float s0 = 0.f, s1 = 0.f;
#pragma unroll
            for (int j = 0; j < 4; ++j) { v0[j] = NTL(xr0 + 64 * j); v1[j] = NTL(xr1 + 64 * j); }
#pragma unroll
            for (int j = 0; j < 4; ++j) { s0 += ssq4(v0[j]); s1 += ssq4(v1[j]); }
            const float rstd0 = 1.f / sqrtf(wave_sum(s0) * (1.f / 1024.f) + EPS), rstd1 = 1.f / sqrtf(wave_sum(s1) * (1.f / 1024.f) + EPS);
            GAS v2u* o80 = (GAS v2u*)(H + (size_t)row0 * 1024) + lane; GAS v2u* o81 = (GAS v2u*)(H + (size_t)row1 * 1024) + lane;
#pragma unroll
            for (int j = 0; j < 4; ++j) { const int c0 = 4 * lane + 256 * j; f32x4 oa, ob;
#pragma unroll
                for (int i = 0; i < 4; ++i) { const float gg = mg[c0 + i] * msc[c0 + i], sh = msh[c0 + i]; oa[i] = (v0[j][i] * rstd0) * gg + sh; ob[i] = (v1[j][i] * rstd1) * gg + sh; }
                NTS(pk4(oa), o80 + 64 * j); if (two) NTS(pk4(ob), o81 + 64 * j); }
        }
        r = e;
    }
    __syncthreads();
}
typedef pg8::f32x4 (AccT)[2][2][4][2];
using pg8::Unit;
#ifdef NT_STORES
__device__ __forceinline__ void st4(bf16* p, f32x4 v) { __builtin_nontemporal_store(pk4(v), (GAS v2u*)p); }
#else
__device__ __forceinline__ void st4(bf16* p, f32x4 v) { *(GAS v2u*)p = pk4(v); }
#endif
__device__ __forceinline__ void st8(bf16* p, f32x4 a, f32x4 b) { v4u w; w.x = pk2(a[0], a[1]); w.y = pk2(a[2], a[3]); w.z = pk2(b[0], b[1]); w.w = pk2(b[2], b[3]);
#ifdef NT_STORES
    __builtin_nontemporal_store(w, (GAS v4u*)p);
#else
    *(GAS v4u*)p = w;
#endif
}
__device__ __forceinline__ void ld8(const bf16* p, f32x4& a, f32x4& b) { const v4u w = *(const GAS v4u*)p; a = unpk4((v2u){w.x, w.y}); b = unpk4((v2u){w.z, w.w}); }
__device__ __forceinline__ f32x4 shx32(f32x4 v) { f32x4 r; r[0] = __shfl_xor(v[0], 32); r[1] = __shfl_xor(v[1], 32); r[2] = __shfl_xor(v[2], 32); r[3] = __shfl_xor(v[3], 32); return r; }
__device__ __forceinline__ void rope_pair(f32x4& x0, f32x4& x1, const float2* cs) {
#pragma unroll
    for (int i = 0; i < 4; ++i) { const float c = cs[i].x, s = cs[i].y, a = x0[i], b = x1[i]; x0[i] = a * c - b * s; x1[i] = b * c + a * s; }
}

__device__ __forceinline__ unsigned gate_q4(f32x4 g) { unsigned r = 0;
#pragma unroll
    for (int i = 0; i < 4; ++i) r |= (unsigned)__builtin_rintf(g[i] * 255.f) << (8 * i);
    return r; }
__device__ __forceinline__ f32x4 gate_dq4(unsigned w) { f32x4 g;
#pragma unroll
    for (int i = 0; i < 4; ++i) g[i] = (float)((w >> (8 * i)) & 255u) * (1.f / 255.f);
    return g; }
__device__ __forceinline__ void ldg8(const unsigned char* p, f32x4& a, f32x4& b) { const v2u w = *(const GAS v2u*)p; a = gate_dq4(w.x); b = gate_dq4(w.y); }
constexpr float QSCALE_MLA = 0.10206207261596575f * 1.4426950408889634f, QSCALE_SWA = 0.125f * 1.4426950408889634f;
struct EpiInProj {
    static constexpr int MID_T = 0;
    bf16 *QA, *KVR, *KR, *KS, *VS, *QS; unsigned char* GT; float *SSQ_Q, *SSQ_KV; const float* b_gate; const float2* RS; const float2* RM;
    __device__ __forceinline__ void operator()(const AccT& acc, const Unit& u, int wr, int wc, int fr, int fq) const {
        const int tin = u.pm % 17; const bool ctx = (tin == 0);
        const int row0 = u.pm * 256 + wr * 64 + fr;
        const int pos0 = (tin - 1) * 256 + wr * 64 + fr;
        const int cw = wc * 32 + fq * 4;
        const int c8 = wc * 32 + fq * 8;
        if (u.pn == 0) {
#pragma unroll
            for (int ai = 0; ai < 2; ++ai)
#pragma unroll
                for (int m = 0; m < 4; ++m) { const int row = row0 + ai * 128 + m * 16; float s = 0.f;
#pragma unroll
                    for (int bj = 0; bj < 2; ++bj) { s += ssq4(acc[ai][bj][m][0]) + ssq4(acc[ai][bj][m][1]); st8(QA + (size_t)row * 256 + bj * 128 + c8, acc[ai][bj][m][0], acc[ai][bj][m][1]); }
                    s += __shfl_xor(s, 16); s += __shfl_xor(s, 32); if (fq == 0) SSQ_Q[(size_t)row * 4 + wc] = s; }
        } else if (u.pn == 1) {
#pragma unroll
            for (int ai = 0; ai < 2; ++ai)
#pragma unroll
                for (int m = 0; m < 4; ++m) { const int row = row0 + ai * 128 + m * 16; float s = 0.f;
                    s += ssq4(acc[ai][0][m][0]) + ssq4(acc[ai][0][m][1]); st8(KVR + (size_t)row * 256 + c8, acc[ai][0][m][0], acc[ai][0][m][1]);
#pragma unroll
                    for (int n = 0; n < 2; ++n) st4(KVR + (size_t)row * 256 + 128 + cw + n * 16, acc[ai][1][m][n]);
                    s += __shfl_xor(s, 16); s += __shfl_xor(s, 32); if (fq == 0) SSQ_KV[(size_t)row * 4 + wc] = s;
                    if (wc == 0) {
                        const int pos = pos0 + ai * 128 + m * 16;
#pragma unroll
                        for (int n = 0; n < 2; ++n) { f32x4 v = acc[ai][1][m][n]; const f32x4 p = shx32(v);
                            if (!ctx) { const int pi = (n == 0) ? (pos >> 6) : (pos & 63); const float2* cs = RM + pi * 8 + (fq & 1) * 4;
#pragma unroll
                                for (int i = 0; i < 4; ++i) v[i] = (fq < 2) ? v[i] * cs[i].x - p[i] * cs[i].y : v[i] * cs[i].x + p[i] * cs[i].y; }
                            st4(KR + (size_t)row * 32 + n * 16 + fq * 4, v); }
                    } }
        } else if (u.pn == 2) {
#pragma unroll
            for (int ai = 0; ai < 2; ++ai)
#pragma unroll
                for (int m = 0; m < 4; ++m) { const int row = row0 + ai * 128 + m * 16; const int pos = pos0 + ai * 128 + m * 16;
                    f32x4 x0 = acc[ai][0][m][0], x1 = acc[ai][0][m][1];
                    if (!ctx) { const int pi = (wc & 1) ? (pos & 63) : (pos >> 6); rope_pair(x0, x1, RS + pi * 16 + fq * 4); }
                    st4(KS + (size_t)row * 128 + cw, x0); st4(KS + (size_t)row * 128 + cw + 16, x1);
                    st8(VS + (size_t)row * 128 + c8, acc[ai][1][m][0], acc[ai][1][m][1]); }
        } else if (u.pn <= 4) {
            const int cb = (u.pn - 3) * 256;
#pragma unroll
            for (int ai = 0; ai < 2; ++ai)
#pragma unroll
                for (int m = 0; m < 4; ++m) { const int row = row0 + ai * 128 + m * 16; const int pos = pos0 + ai * 128 + m * 16;
                    const int pi = (wc & 1) ? (pos & 63) : (pos >> 6); const float2* cs = RS + pi * 16 + fq * 4;
#pragma unroll
                    for (int bj = 0; bj < 2; ++bj) { f32x4 x0 = acc[ai][bj][m][0] * QSCALE_SWA, x1 = acc[ai][bj][m][1] * QSCALE_SWA; rope_pair(x0, x1, cs);
                        st4(QS + (size_t)row * 512 + cb + bj * 128 + cw, x0); st4(QS + (size_t)row * 512 + cb + bj * 128 + cw + 16, x1); } }
        } else {
            const int cb = (u.pn - 5) * 256, c16 = wc * 64 + fq * 16;
            f32x4 bv[2][2];
#pragma unroll
            for (int bj = 0; bj < 2; ++bj)
#pragma unroll
                for (int n = 0; n < 2; ++n) bv[bj][n] = *(const f32x4*)(b_gate + cb + c16 + bj * 8 + n * 4);
#pragma unroll
            for (int ai = 0; ai < 2; ++ai)
#pragma unroll
                for (int m = 0; m < 4; ++m) { const int row = row0 + ai * 128 + m * 16; v4u w;
#pragma unroll
                    for (int bj = 0; bj < 2; ++bj) { f32x4 v0 = acc[ai][bj][m][0] + bv[bj][0], v1 = acc[ai][bj][m][1] + bv[bj][1];
#pragma unroll
                        for (int i = 0; i < 4; ++i) { v0[i] = sigmoid_f(v0[i]); v1[i] = sigmoid_f(v1[i]); }
                        if (bj == 0) { w.x = gate_q4(v0); w.y = gate_q4(v1); } else { w.z = gate_q4(v0); w.w = gate_q4(v1); } }
                    *(GAS v4u*)(GT + (size_t)row * 2048 + cb + c16) = w; }
        }
    }
};
struct EpiQUp {
    static constexpr int MID_T = 0;
    bf16 *QN, *QR; const float* SSQ_Q; const float2* RM;
    __device__ __forceinline__ void operator()(const AccT& acc, const Unit& u, int wr, int wc, int fr, int fq) const {
        const int tin = u.pm % 17; const int row0 = u.pm * 256 + wr * 64 + fr, pos0 = (tin - 1) * 256 + wr * 64 + fr, cw = wc * 32 + fq * 4;
#pragma unroll
        for (int ai = 0; ai < 2; ++ai)
#pragma unroll
            for (int m = 0; m < 4; ++m) { const int row = row0 + ai * 128 + m * 16; const int pos = pos0 + ai * 128 + m * 16;
                asm volatile("" ::: "memory"); __builtin_amdgcn_sched_barrier(0);
                const f32x4 sq = *(const f32x4*)(SSQ_Q + (size_t)row * 4); const float rs = QSCALE_MLA / sqrtf(((sq[0] + sq[1]) + (sq[2] + sq[3])) * (1.f / 256.f) + EPS);
                if (u.pn < 2) {
#pragma unroll
                    for (int bj = 0; bj < 2; ++bj) st8(QN + (size_t)row * 512 + u.pn * 256 + bj * 128 + wc * 32 + fq * 8, acc[ai][bj][m][0] * rs, acc[ai][bj][m][1] * rs);
                } else {
#pragma unroll
                    for (int bj = 0; bj < 2; ++bj)
#pragma unroll
                        for (int n = 0; n < 2; ++n) { f32x4 v = acc[ai][bj][m][n] * rs; const f32x4 p = shx32(v);
                            const int pi = (n == 0) ? (pos >> 6) : (pos & 63); const float2* cs = RM + pi * 8 + (fq & 1) * 4;
#pragma unroll
                            for (int i = 0; i < 4; ++i) v[i] = (fq < 2) ? v[i] * cs[i].x - p[i] * cs[i].y : v[i] * cs[i].x + p[i] * cs[i].y;
                            st4(QR + (size_t)row * 256 + (bj * 4 + wc) * 32 + n * 16 + fq * 4, v); }
                } }
    }
};
struct EpiKVUp {
    static constexpr int MID_T = 0;
    bf16 *KN, *VM; const float* SSQ_KV;
    __device__ __forceinline__ void operator()(const AccT& acc, const Unit& u, int wr, int wc, int fr, int fq) const {
        const int row0 = u.pm * 256 + wr * 64 + fr, cw = wc * 32 + fq * 4;
        bf16* dst = (u.pn < 2) ? KN + u.pn * 256 : VM + (u.pn - 2) * 256;
#pragma unroll
        for (int ai = 0; ai < 2; ++ai)
#pragma unroll
            for (int m = 0; m < 4; ++m) { const int row = row0 + ai * 128 + m * 16;
                asm volatile("" ::: "memory"); __builtin_amdgcn_sched_barrier(0);
                const f32x4 sq = *(const f32x4*)(SSQ_KV + (size_t)row * 4); const float rs = 1.f / sqrtf(((sq[0] + sq[1]) + (sq[2] + sq[3])) * (1.f / 128.f) + EPS);
#pragma unroll
                for (int bj = 0; bj < 2; ++bj) st8(dst + (size_t)row * 512 + bj * 128 + wc * 32 + fq * 8, acc[ai][bj][m][0] * rs, acc[ai][bj][m][1] * rs); }
    }
};
struct EpiMerge {
    static constexpr int MID_T = 8;
    bf16* M1; const unsigned char* GT;
    __device__ __forceinline__ void mid(AccT& acc, const Unit& u, int wr, int wc, int fr, int fq) const {
        const int row0 = u.pm * 256 + wr * 64 + fr, c0 = u.pn * 256 + wc * 32 + fq * 8;
#pragma unroll
        for (int ai = 0; ai < 2; ++ai)
#pragma unroll
            for (int m = 0; m < 4; ++m) { const int row = row0 + ai * 128 + m * 16;
#pragma unroll
                for (int bj = 0; bj < 2; ++bj) { const int col = c0 + bj * 128;
                    f32x4 ga0, ga1, gb0, gb1; ldg8(GT + (size_t)row * 2048 + col, ga0, ga1); ldg8(GT + (size_t)row * 2048 + 1024 + col, gb0, gb1);
#pragma unroll
                    for (int i = 0; i < 4; ++i) { acc[ai][bj][m][0][i] *= ga0[i] * __builtin_amdgcn_rcpf(fmaxf(gb0[i], 1e-18f)); acc[ai][bj][m][1][i] *= ga1[i] * __builtin_amdgcn_rcpf(fmaxf(gb1[i], 1e-18f)); } } }
    }
    __device__ __forceinline__ void operator()(const AccT& acc, const Unit& u, int wr, int wc, int fr, int fq) const {
        const int row0 = u.pm * 256 + wr * 64 + fr, c0 = u.pn * 256 + wc * 32 + fq * 8;
#pragma unroll
        for (int ai = 0; ai < 2; ++ai)
#pragma unroll
            for (int m = 0; m < 4; ++m) { const int row = row0 + ai * 128 + m * 16;
#pragma unroll
                for (int bj = 0; bj < 2; ++bj) { const int col = c0 + bj * 128;
                    f32x4 gb0, gb1, o0, o1; ldg8(GT + (size_t)row * 2048 + 1024 + col, gb0, gb1);
#pragma unroll
                    for (int i = 0; i < 4; ++i) { o0[i] = fmaxf(gb0[i], 1e-18f) * acc[ai][bj][m][0][i]; o1[i] = fmaxf(gb1[i], 1e-18f) * acc[ai][bj][m][1][i]; }
                    st8(M1 + (size_t)row * 1024 + col, o0, o1); } }
    }
};
template <int XV> struct EpiMergeX {
    static constexpr int MID_T = (XV & 1) ? 0 : 8;
    bf16* M1; const unsigned char* GT;
    __device__ __forceinline__ void mid(AccT& acc, const Unit& u, int wr, int wc, int fr, int fq) const {
        const int row0 = u.pm * 256 + wr * 64 + fr, c0 = u.pn * 256 + wc * 32 + fq * 8;
#pragma unroll
        for (int ai = 0; ai < 2; ++ai)
#pragma unroll
            for (int m = 0; m < 4; ++m) { const int row = row0 + ai * 128 + m * 16;
#pragma unroll
                for (int bj = 0; bj < 2; ++bj) { const int col = c0 + bj * 128;
                    f32x4 ga0, ga1, gb0, gb1; ldg8(GT + (size_t)row * 2048 + col, ga0, ga1); ldg8(GT + (size_t)row * 2048 + 1024 + col, gb0, gb1);
#pragma unroll
                    for (int i = 0; i < 4; ++i) { acc[ai][bj][m][0][i] *= ga0[i] * __builtin_amdgcn_rcpf(fmaxf(gb0[i], 1e-18f)); acc[ai][bj][m][1][i] *= ga1[i] * __builtin_amdgcn_rcpf(fmaxf(gb1[i], 1e-18f)); } } }
    }
    __device__ __forceinline__ void operator()(const AccT& acc, const Unit& u, int wr, int wc, int fr, int fq) const {
        const int row0 = u.pm * 256 + wr * 64 + fr, c0 = u.pn * 256 + wc * 32 + fq * 8;
#pragma unroll
        for (int ai = 0; ai < 2; ++ai)
#pragma unroll
            for (int m = 0; m < 4; ++m) { const int row = row0 + ai * 128 + m * 16;
#pragma unroll
                for (int bj = 0; bj < 2; ++bj) { const int col = c0 + bj * 128;
                    f32x4 gb0, gb1, o0, o1; if (XV & 2) { gb0 = (f32x4){0.5f, 0.5f, 0.5f, 0.5f}; gb1 = gb0; } else ldg8(GT + (size_t)row * 2048 + 1024 + col, gb0, gb1);
#pragma unroll
                    for (int i = 0; i < 4; ++i) { o0[i] = fmaxf(gb0[i], 1e-18f) * acc[ai][bj][m][0][i]; o1[i] = fmaxf(gb1[i], 1e-18f) * acc[ai][bj][m][1][i]; }
                    st8(M1 + (size_t)row * 1024 + col, o0, o1); } }
    }
};
struct EpiOutSsq {
    static constexpr int MID_T = 0;
    bf16* O; float* SSQ;
    __device__ __forceinline__ void operator()(const AccT& acc, const Unit& u, int wr, int wc, int fr, int fq) const {
        const int row0 = u.pm * 256 + wr * 64 + fr, c0 = u.pn * 256 + wc * 32 + fq * 8;
#pragma unroll
        for (int ai = 0; ai < 2; ++ai)
#pragma unroll
            for (int m = 0; m < 4; ++m) { const int row = row0 + ai * 128 + m * 16; float s = 0.f;
#pragma unroll
                for (int bj = 0; bj < 2; ++bj) { s += ssq4(acc[ai][bj][m][0]) + ssq4(acc[ai][bj][m][1]); st8(O + (size_t)row * 1024 + c0 + bj * 128, acc[ai][bj][m][0], acc[ai][bj][m][1]); }
                s += __shfl_xor(s, 16); s += __shfl_xor(s, 32); if (fq == 0) SSQ[(size_t)row * 16 + u.pn * 4 + wc] = s; }
    }
};
__device__ __forceinline__ f32x4 bperm4(int addr, f32x4 v) { f32x4 r;
#pragma unroll
    for (int i = 0; i < 4; ++i) r[i] = __int_as_float(__builtin_amdgcn_ds_bpermute(addr, __float_as_int(v[i])));
    return r; }
template <int CTRL> __device__ __forceinline__ f32x4 dpp4(f32x4 v) { f32x4 r;
#pragma unroll
    for (int i = 0; i < 4; ++i) r[i] = __int_as_float(__builtin_amdgcn_update_dpp(0, __float_as_int(v[i]), CTRL, 0xf, 0xf, false));
    return r; }
#ifndef DPP_PREV
#define DPP_PREV 0x121
#define DPP_NEXT 0x12F
#endif
__device__ __forceinline__ f32x4 sel4(bool c, f32x4 a, f32x4 b) { f32x4 r;
#pragma unroll
    for (int i = 0; i < 4; ++i) r[i] = c ? a[i] : b[i];
    return r; }
struct EpiNull {
    static constexpr int MID_T = 0; float* O;
    __device__ __forceinline__ void operator()(const AccT& acc, const Unit& u, int wr, int wc, int fr, int fq) const {
        f32x4 s = acc[0][0][0][0];
#pragma unroll
        for (int ai = 0; ai < 2; ++ai)
#pragma unroll
            for (int bj = 0; bj < 2; ++bj)
#pragma unroll
                for (int m = 0; m < 4; ++m)
#pragma unroll
                    for (int n = 0; n < 2; ++n) s = s + acc[ai][bj][m][n];
        if (s[0] + s[1] + s[2] + s[3] == 12345.678f) O[(u.pm * 4 + u.pn) * 512 + (wr * 4 + wc) * 64 + fq * 16 + fr] = s[0];
    }
};
struct EpiStoreOnly { static constexpr int MID_T = 0; bf16* O;
    __device__ __forceinline__ void operator()(const AccT& acc, const Unit& u, int wr, int wc, int fr, int fq) const {
        const int row0 = u.pm * 256 + wr * 64 + fr, c0 = u.pn * 256 + wc * 32 + fq * 8;
#pragma unroll
        for (int ai = 0; ai < 2; ++ai)
#pragma unroll
            for (int m = 0; m < 4; ++m) { const int row = row0 + ai * 128 + m * 16;
#pragma unroll
                for (int bj = 0; bj < 2; ++bj) st8(O + (size_t)row * 1024 + c0 + bj * 128, acc[ai][bj][m][0], acc[ai][bj][m][1]); }
    } };
struct EpiSsqOnly { static constexpr int MID_T = 0; float* SSQ;
    __device__ __forceinline__ void operator()(const AccT& acc, const Unit& u, int wr, int wc, int fr, int fq) const {
        const int row0 = u.pm * 256 + wr * 64 + fr;
#pragma unroll
        for (int ai = 0; ai < 2; ++ai)
#pragma unroll
            for (int m = 0; m < 4; ++m) { const int row = row0 + ai * 128 + m * 16; float s = 0.f;
#pragma unroll
                for (int bj = 0; bj < 2; ++bj) s += ssq4(acc[ai][bj][m][0]) + ssq4(acc[ai][bj][m][1]);
                s += __shfl_xor(s, 16); s += __shfl_xor(s, 32); if (fq == 0) SSQ[(size_t)row * 16 + u.pn * 4 + wc] = s; }
    } };
struct EpiUp {
    static constexpr int MID_T = 0;
    bf16* ACT; float* SB; const float* cw; const float* cb;
    __device__ __forceinline__ void operator()(AccT& acc, const Unit& u, int wr, int wc, int fr, int fq) const {
        const int lane = fq * 16 + fr;
        const int src_prev = ((lane & 48) | ((fr + 15) & 15)) << 2, src_next = ((lane & 48) | ((fr + 1) & 15)) << 2; (void)src_prev; (void)src_next;
        const int bat = u.pm / 17, tin = u.pm % 17;
        const int colw = wc * 32 + fq * 8;
        const bool lo = fr < 2, bnd = lo || fr >= 14; const int which = lo ? fr : fr - 12;
        const bool f0 = (fr == 0), f15 = (fr == 15);
#pragma unroll
        for (int ai = 0; ai < 2; ++ai) {
            const int chunk = (bat * SEQ + (tin - 1) * 256 + ai * 128 + wr * 64) >> 6;
            if (bnd) {
                float* sb = SB + ((size_t)chunk * 4 + which) * DUP + u.pn * 256 + colw;
#pragma unroll
                for (int bj = 0; bj < 2; ++bj)
#pragma unroll
                    for (int n = 0; n < 2; ++n) *(GAS f32x4*)(sb + bj * 128 + n * 4) = lo ? acc[ai][bj][0][n] : acc[ai][bj][3][n];
            }
            const size_t rowb = (size_t)(u.pm * 256 + ai * 128 + wr * 64 + fr);
#pragma unroll
            for (int n = 0; n < 2; ++n) {
#pragma unroll
                for (int bj = 0; bj < 2; ++bj) {
                    asm volatile("" ::: "memory"); __builtin_amdgcn_sched_barrier(0);
                    const int oc = bj * DFF + u.pn * 128 + colw + n * 4;
                    const f32x4 w0 = *(const f32x4*)(cw + oc), w1 = *(const f32x4*)(cw + DUP + oc), w2 = *(const f32x4*)(cw + 2 * DUP + oc), bb = *(const f32x4*)(cb + oc);
                    const f32x4 a0 = acc[ai][bj][0][n], a1 = acc[ai][bj][1][n], a2 = acc[ai][bj][2][n], a3 = acc[ai][bj][3][n];
#ifdef CONV_BPERMUTE
                    const f32x4 p0 = bperm4(src_prev, a0), p1 = bperm4(src_prev, a1), p2 = bperm4(src_prev, a2), p3 = bperm4(src_prev, a3);
                    const f32x4 n0 = bperm4(src_next, a0), n1 = bperm4(src_next, a1), n2 = bperm4(src_next, a2), n3 = bperm4(src_next, a3);
#else
                    const f32x4 p0 = dpp4<DPP_PREV>(a0), p1 = dpp4<DPP_PREV>(a1), p2 = dpp4<DPP_PREV>(a2), p3 = dpp4<DPP_PREV>(a3);
                    const f32x4 n0 = dpp4<DPP_NEXT>(a0), n1 = dpp4<DPP_NEXT>(a1), n2 = dpp4<DPP_NEXT>(a2), n3 = dpp4<DPP_NEXT>(a3);
#endif
                    acc[ai][bj][0][n] = bb + w0 * sel4(f0, p3, p0) + w1 * a0 + w2 * sel4(f15, n1, n0);
                    acc[ai][bj][1][n] = bb + w0 * sel4(f0, p0, p1) + w1 * a1 + w2 * sel4(f15, n2, n1);
                    acc[ai][bj][2][n] = bb + w0 * sel4(f0, p1, p2) + w1 * a2 + w2 * sel4(f15, n3, n2);
                    acc[ai][bj][3][n] = bb + w0 * sel4(f0, p2, p3) + w1 * a3 + w2 * sel4(f15, n0, n3);
                }
            }
            asm volatile("" ::: "memory"); __builtin_amdgcn_sched_barrier(0);
#pragma unroll
            for (int m = 0; m < 4; ++m) {
                f32x4 o0, o1;
#pragma unroll
                for (int i = 0; i < 4; ++i) { o0[i] = silu_f(acc[ai][0][m][0][i]) * acc[ai][1][m][0][i]; o1[i] = silu_f(acc[ai][0][m][1][i]) * acc[ai][1][m][1][i]; }
                st8(ACT + (rowb + m * 16) * DFF + u.pn * 128 + colw, o0, o1);
            }
        }
    }
};
__device__ __forceinline__ void p4_attention(const Args& a, char* lds, int vcu, int tid) {
    unsigned char* ws = a.ws;
    const bf16* QN = (const bf16*)(ws + WS_QN); const bf16* QR = (const bf16*)(ws + WS_QR); const bf16* KN = (const bf16*)(ws + WS_KN); const bf16* KR = (const bf16*)(ws + WS_KR); const bf16* VM = (const bf16*)(ws + WS_VM);
    const bf16* QS = (const bf16*)(ws + WS_QS); const bf16* KS = (const bf16*)(ws + WS_KS); const bf16* VS = (const bf16*)(ws + WS_VS); bf16* O2 = (bf16*)(ws + WS_H);
#ifndef REP_MLA
#define REP_MLA 1
#endif
#ifndef REP_SWA
#define REP_SWA 1
#endif
    for (int i = 0; i < 4 * REP_MLA; ++i) {
        const int unit = (i & 3) * 256 + vcu; if (unit >= 1024) break;
        const int bh = unit >> 4, qb = unit & 15, b = bh >> 3, h = bh & 7;
        const size_t krow0 = (size_t)b * TPB, qrow0 = krow0 + CTX + qb * 256;
        att::AttnIO io;
        io.Q1 = QN + qrow0 * 512 + h * 64; io.Q2 = QR + qrow0 * 256 + h * 32;
        io.K1 = KN + krow0 * 512 + h * 64; io.K2 = KR + krow0 * 32;
        io.V = VM + krow0 * 512 + h * 64; io.O = O2 + qrow0 * 1024 + h * 64;
        att::attn_unit<false>(io, qb * 256, 0.f, lds, tid);
    }
#ifdef XVAR
    for (int i = 0; i < 4; ++i) {
        const int unit = i * 256 + vcu; if (unit >= 1024) break;
        const int bh = unit >> 4, qb = unit & 15, b = bh >> 3, h = bh & 7;
        const size_t krow0 = (size_t)b * TPB, qrow0 = krow0 + CTX + qb * 256;
        att::AttnIO io;
        io.Q1 = QN + qrow0 * 512 + h * 64; io.Q2 = QR + qrow0 * 256 + h * 32;
        io.K1 = KN + krow0 * 512 + h * 64; io.K2 = KR + krow0 * 32;
        io.V = VM + krow0 * 512 + h * 64; io.O = (bf16*)(ws + WS_F) + qrow0 * 1024 + h * 64;
        att::attn_unit<false, XVAR>(io, qb * 256, 0.f, lds, tid);
    }
#endif
    for (int i = 0; i < 4 * REP_SWA; ++i) {
        const int unit = (i & 3) * 256 + vcu; if (unit >= 1024) break;
        const int bh = unit >> 4, qb = unit & 15, b = bh >> 3, h = bh & 7, kvh = h >> 2;
        const size_t krow0 = (size_t)b * TPB, qrow0 = krow0 + CTX + qb * 256;
        att::AttnIO io;
        io.Q1 = QS + qrow0 * 512 + h * 64; io.Q2 = nullptr;
        io.K1 = KS + krow0 * 128 + kvh * 64; io.K2 = nullptr;
        io.V = VS + krow0 * 128 + kvh * 64; io.O = O2 + qrow0 * 1024 + 512 + h * 64;
        att::attn_unit<true>(io, qb * 256, a.in[I_SINK][h], lds, tid);
    }
}
__device__ __forceinline__ void p7_resid_norm(const Args& a, LAS unsigned char* lds, int vcu, int G, int tid, int lane, int wave) {
    unsigned char* ws = a.ws; const float* MODF = (const float*)(ws + WS_MODF); const bf16* AL = (const bf16*)(ws + WS_AL); const float* SSQ = (const float*)(ws + WS_SSQ_16); bf16* HF = (bf16*)(ws + WS_H);
    LAS float* vpg = (LAS float*)lds; LAS float* vg1 = vpg + 1024; LAS float* vfg = vg1 + 1024; LAS float* vsh = vfg + 1024; LAS float* vsc = vsh + 1024;
    const int rows_per = (RL + G - 1) / G;
    int r = vcu * rows_per; const int rend = (r + rows_per < RL) ? r + rows_per : RL;
    while (r < rend) {
        const int b = r / SEQ; const int seg_end = (b + 1) * SEQ; const int e = seg_end < rend ? seg_end : rend;
        __syncthreads();
        for (int j = tid; j < 1024; j += 512) { vpg[j] = a.in[I_APOST][j]; vg1[j] = MODF[b * 6144 + 2048 + j]; vfg[j] = a.in[I_FPRE][j]; vsh[j] = MODF[b * 6144 + 3072 + j]; vsc[j] = 1.f + MODF[b * 6144 + 4096 + j]; }
        __syncthreads();
        for (int rl = r + wave; rl < e; rl += NWAVES) {
            const size_t row = (size_t)b * TPB + CTX + (rl - b * SEQ);
            const f32x4* sp = (const f32x4*)(SSQ + row * 16); const f32x4 s0 = sp[0], s1 = sp[1], s2 = sp[2], s3 = sp[3];
            const float ssq = ((s0[0] + s0[1]) + (s0[2] + s0[3])) + ((s1[0] + s1[1]) + (s1[2] + s1[3])) + ((s2[0] + s2[1]) + (s2[2] + s2[3])) + ((s3[0] + s3[1]) + (s3[2] + s3[3]));
            const float rstd1 = 1.f / sqrtf(ssq * (1.f / 1024.f) + EPS);
            const GAS f32x4* xr = (const GAS f32x4*)(a.in[I_X] + (size_t)rl * 1024) + lane; GAS f32x4* xo = (GAS f32x4*)(a.out + (size_t)rl * 1024) + lane;
            const GAS v2u* ar = (const GAS v2u*)(AL + row * 1024) + lane;
            f32x4 v[4]; float s = 0.f;
#pragma unroll
            for (int j = 0; j < 4; ++j) { const int c0 = 4 * lane + 256 * j; const f32x4 x = NTL(xr + 64 * j); const f32x4 al = unpk4(NTL(ar + 64 * j));
#pragma unroll
                for (int i = 0; i < 4; ++i) v[j][i] = x[i] + vg1[c0 + i] * (al[i] * rstd1 * vpg[c0 + i]);
                NTS(v[j], xo + 64 * j); s += ssq4(v[j]); }
            const float rstd2 = 1.f / sqrtf(wave_sum(s) * (1.f / 1024.f) + EPS);
            GAS v2u* o8 = (GAS v2u*)(HF + row * 1024) + lane;
#pragma unroll
            for (int j = 0; j < 4; ++j) { const int c0 = 4 * lane + 256 * j; f32x4 o;
#pragma unroll
                for (int i = 0; i < 4; ++i) o[i] = (v[j][i] * rstd2 * vfg[c0 + i]) * vsc[c0 + i] + vsh[c0 + i];
                NTS(pk4(o), o8 + 64 * j); }
        }
        r = e;
    }
    __syncthreads();
}
__device__ __forceinline__ void p9_conv_fix(const Args& a, int vcu, int G, int lane, int wave) {
    unsigned char* ws = a.ws; const float* SB = (const float*)(ws + WS_SB); bf16* ACT = (bf16*)(ws + WS_ACT); const float* cw = a.in[I_CONVW]; const float* cb = a.in[I_CONVB];
    const int gw = vcu * NWAVES + wave, NGW = G * NWAVES;
    for (int task = gw; task < 2 * 512; task += NGW) {
        const int chunk = task >> 1, last = task & 1;
        const int t = chunk * 64 + (last ? 63 : 0);
        const int b = t / SEQ, pos = t % SEQ; const size_t row = (size_t)b * TPB + CTX + pos;
        const float* cur = SB + ((size_t)chunk * 4 + (last ? 3 : 0)) * DUP;
        const float* prv = last ? SB + ((size_t)chunk * 4 + 2) * DUP : (pos == 0 ? nullptr : SB + ((size_t)(chunk - 1) * 4 + 3) * DUP);
        const float* nxt = last ? (pos == SEQ - 1 ? nullptr : SB + ((size_t)(chunk + 1) * 4 + 0) * DUP) : SB + ((size_t)chunk * 4 + 1) * DUP;
        for (int cc = lane; cc < DFF; cc += 64) {
            const int pg = (cc >> 7) * 256 + (cc & 127), pv = pg + 128;
            const float gp = prv ? prv[pg] : 0.f, gc = cur[pg], gn = nxt ? nxt[pg] : 0.f, vp = prv ? prv[pv] : 0.f, vc = cur[pv], vn = nxt ? nxt[pv] : 0.f;
            const float ug = cb[cc] + cw[cc] * gp + cw[DUP + cc] * gc + cw[2 * DUP + cc] * gn;
            const float uv = cb[DFF + cc] + cw[DFF + cc] * vp + cw[DUP + DFF + cc] * vc + cw[2 * DUP + DFF + cc] * vn;
            ACT[row * DFF + cc] = (bf16)(pk2(silu_f(ug) * uv, 0.f) & 0xffffu);
        }
    }
}
#ifndef EXP_FFN_SCALE
#define EXP_FFN_SCALE 1.f
#endif
__device__ __forceinline__ void p11_final(const Args& a, LAS unsigned char* lds, int vcu, int G, int tid, int lane, int wave) {
    unsigned char* ws = a.ws; const float* MODF = (const float*)(ws + WS_MODF); const bf16* F = (const bf16*)(ws + WS_F); const float* SSQ = (const float*)(ws + WS_SSQ_16);
    LAS float* vpg = (LAS float*)lds; LAS float* vg2 = vpg + 1024;
    const int rows_per = (RL + G - 1) / G;
    int r = vcu * rows_per; const int rend = (r + rows_per < RL) ? r + rows_per : RL;
    while (r < rend) {
        const int b = r / SEQ; const int seg_end = (b + 1) * SEQ; const int e = seg_end < rend ? seg_end : rend;
        __syncthreads();
        for (int j = tid; j < 1024; j += 512) { vpg[j] = a.in[I_FPOST][j]; vg2[j] = MODF[b * 6144 + 5120 + j]; }
        __syncthreads();
        for (int rl = r + wave; rl < e; rl += NWAVES) {
            const size_t row = (size_t)b * TPB + CTX + (rl - b * SEQ);
            const f32x4* sp = (const f32x4*)(SSQ + row * 16); const f32x4 s0 = sp[0], s1 = sp[1], s2 = sp[2], s3 = sp[3];
            const float ssq = ((s0[0] + s0[1]) + (s0[2] + s0[3])) + ((s1[0] + s1[1]) + (s1[2] + s1[3])) + ((s2[0] + s2[1]) + (s2[2] + s2[3])) + ((s3[0] + s3[1]) + (s3[2] + s3[3]));
            const float rstd = 1.f / sqrtf(ssq * (1.f / 1024.f) + EPS);
            GAS f32x4* xo = (GAS f32x4*)(a.out + (size_t)rl * 1024) + lane; const GAS v2u* fr_ = (const GAS v2u*)(F + row * 1024) + lane;
#pragma unroll
            for (int j = 0; j < 4; ++j) { const int c0 = 4 * lane + 256 * j; f32x4 x = NTL(xo + 64 * j); const f32x4 f = unpk4(NTL(fr_ + 64 * j));
#pragma unroll
                for (int i = 0; i < 4; ++i) x[i] = x[i] + EXP_FFN_SCALE * vg2[c0 + i] * (f[i] * rstd * vpg[c0 + i]);
                NTS(x, xo + 64 * j); }
        }
        r = e;
    }
}

__device__ __forceinline__ int lane_id_volatile() { int l; asm volatile("v_mbcnt_lo_u32_b32 %0, -1, 0\n\tv_mbcnt_hi_u32_b32 %0, -1, %0" : "=v"(l)); return l; }

#ifdef DEBUG_FFN
constexpr int DBG_W = 8192;
__device__ __forceinline__ unsigned dbg_hash(unsigned x) { x ^= x >> 16; x *= 0x7feb352du; x ^= x >> 15; x *= 0x846ca68bu; x ^= x >> 16; return x; }
__device__ __forceinline__ void dbg_check_act(const Args& a, int vcu, int G, int lane, int wave) {
    unsigned char* ws = a.ws; const bf16* HF = (const bf16*)(ws + WS_H); const bf16* ACT = (const bf16*)(ws + WS_ACT); unsigned* ctl = (unsigned*)(ws + WS_CTL);
    const float* wup = a.in[I_WUP]; const float* cw = a.in[I_CONVW]; const float* cb = a.in[I_CONVB];
    const int s = vcu * NWAVES + wave;
    const unsigned h1 = dbg_hash(s * 3 + 1), h2 = dbg_hash(s * 3 + 2), h3 = dbg_hash(s * 3 + 3);
    const int type = s % 5, chunk = h1 % 512;
    int ric = 0;
    if (type == 0) ric = 16 * (h2 % 4) + 1 + (h3 % 14); else if (type == 1) ric = 16 * (1 + h2 % 3); else if (type == 2) ric = 16 * (h2 % 3) + 15; else if (type == 3) ric = 0; else ric = 63;
    const int t = chunk * 64 + ric, b = t / SEQ, pos = t % SEQ, cc = (h3 >> 8) % DFF;
    float ug = cb[cc], uv = cb[DFF + cc];
    for (int j = 0; j < 3; ++j) {
        const int pp = pos + j - 1; if (pp < 0 || pp >= SEQ) continue;
        const bf16* hr = HF + ((size_t)b * TPB + CTX + pp) * 1024;
        float sg = 0.f, sv = 0.f;
        for (int k = lane; k < 1024; k += 64) { const float hv = bf2f(hr[k]); sg += hv * wup[(size_t)k * DUP + cc]; sv += hv * wup[(size_t)k * DUP + DFF + cc]; }
        sg = wave_sum(sg); sv = wave_sum(sv);
        ug += cw[j * DUP + cc] * sg; uv += cw[j * DUP + DFF + cc] * sv;
    }
    const float ref = silu_f(ug) * uv; const float got = bf2f(ACT[((size_t)b * TPB + CTX + pos) * DFF + cc]);
    const float d = fabsf(ref - got);
    if (lane == 0) { if (d > 0.03f + 0.03f * fabsf(ref)) atomicOr(ctl + DBG_W, 1u << type); atomicMax(ctl + DBG_W + 1, (unsigned)(d * 1000.f)); }
}
#endif
__global__ void __launch_bounds__(NWAVES * 64, 2) fwd_kernel(Args args) {
    extern __shared__ __attribute__((aligned(16))) unsigned char lds_raw[];
    LAS unsigned char* lds = (LAS unsigned char*)lds_raw;
    volatile LAS unsigned* MISC = (volatile LAS unsigned*)(lds + MISC_OFF);
    const int tid0 = threadIdx.x; const int wave0 = __builtin_amdgcn_readfirstlane(tid0 >> 6);
#define TID() (wave0 * 64 + lane_id_volatile())
    const int G = gridDim.x; const int bx = blockIdx.x; const int vcu = (G % 8 == 0) ? (bx % 8) * (G / 8) + bx / 8 : bx;
    unsigned char* ws = args.ws;
    for (int u = tid0; u < (LDS_BYTES - RING_BYTES) / 4; u += NWAVES * 64) ((LAS unsigned*)(lds + RING_BYTES))[u] = 0u;
    __syncthreads();
    XcdBarrier bar = xcd_barrier_post((unsigned*)(ws + WS_CTL), MISC + 8);
#define GRID_BAR() xcd_barrier(bar)
#ifndef STG2
#define STG2 0
#define STG8 0
#endif
    const int odd_cu = (bx >> 3) & 1;
#ifndef REP_PHASE
#define REP_PHASE -1
#endif
#ifndef REP_COUNT
#define REP_COUNT 2
#endif
#define REPS(n) ((n) == REP_PHASE ? REP_COUNT : 1)
    bf16* H = (bf16*)(ws + WS_H);
#define PH(n) (!defined(ONLY) || ONLY == (n))
    asm volatile("; PHASE_MARK 0");
#if !defined(ONLY) || ONLY == 0
    for (int rep_ = 0; rep_ < REPS(0); ++rep_) { if (rep_) GRID_BAR();
    { int tid = TID(); asm volatile("" : "+v"(tid)); const int lane = tid & 63, wave = __builtin_amdgcn_readfirstlane(tid >> 6); p0_prologue(args, lds, vcu, G, tid, lane, wave); }
    }
#endif
    GRID_BAR();
    asm volatile("; PHASE_MARK 1");
#if !defined(ONLY) || ONLY == 1
    for (int rep_ = 0; rep_ < REPS(1); ++rep_) { if (rep_) GRID_BAR();
    { int tid = TID(); asm volatile("" : "+v"(tid)); const int lane = tid & 63, wave = __builtin_amdgcn_readfirstlane(tid >> 6); p1_norm_mod(args, lds, vcu, G, tid, lane, wave); }
    }
#endif
    GRID_BAR();
    asm volatile("; PHASE_MARK 2");
#if !defined(ONLY) || ONLY == 2
    for (int rep_ = 0; rep_ < REPS(2); ++rep_) { if (rep_) GRID_BAR();
    {
        pg8::Gemm g{H, (const bf16*)(ws + WS_WIN), 1024, 1024, 1024}; pg8::Order<2> S{13, G, bx};
        EpiInProj E{(bf16*)(ws + WS_QA), (bf16*)(ws + WS_KVR), (bf16*)(ws + WS_KR), (bf16*)(ws + WS_KS), (bf16*)(ws + WS_VS), (bf16*)(ws + WS_QS), (unsigned char*)(ws + WS_G),
                    (float*)(ws + WS_SSQ_Q), (float*)(ws + WS_SSQ_KV), args.in[I_BGATE], (const float2*)(ws + WS_ROPE_S), (const float2*)(ws + WS_ROPE_M)};
        pg8::gemm_phase(lds, g, S, E, TID(), odd_cu * STG2);
    }
    }
#endif
    GRID_BAR();
    asm volatile("; PHASE_MARK 3");
#if (!defined(ONLY) || ONLY == 3) && !defined(NO3A)
    for (int rep_ = 0; rep_ < REPS(3); ++rep_) { if (rep_) GRID_BAR();
    {
        pg8::Gemm g{(const bf16*)(ws + WS_QA), (const bf16*)(ws + WS_WQ), 256, 256, 256}; pg8::Order<1> S{3, G, bx};
        EpiQUp E{(bf16*)(ws + WS_QN), (bf16*)(ws + WS_QR), (const float*)(ws + WS_SSQ_Q), (const float2*)(ws + WS_ROPE_M)};
        pg8::gemm_phase(lds, g, S, E, TID());
    }
    }
#endif
#if (!defined(ONLY) || ONLY == 3) && !defined(NO3B)
    for (int rep_ = 0; rep_ < REPS(3); ++rep_) { if (rep_) GRID_BAR();
    {
        pg8::Gemm g{(const bf16*)(ws + WS_KVR), (const bf16*)(ws + WS_WKV), 256, 256, 256}; pg8::Order<0> S{4, G, bx};
        EpiKVUp E{(bf16*)(ws + WS_KN), (bf16*)(ws + WS_VM), (const float*)(ws + WS_SSQ_KV)};
        pg8::gemm_phase(lds, g, S, E, TID());
    }
    }
#endif
    GRID_BAR();
    asm volatile("; PHASE_MARK 4");
#if !defined(ONLY) || ONLY == 4
    for (int rep_ = 0; rep_ < REPS(4); ++rep_) { if (rep_) GRID_BAR();
    p4_attention(args, (char*)lds_raw, vcu, TID());
    }
#endif
    GRID_BAR();
    asm volatile("; PHASE_MARK 5");
#if !defined(ONLY) || ONLY == 5
    for (int rep_ = 0; rep_ < REPS(5); ++rep_) { if (rep_) GRID_BAR();
    {
        pg8::Gemm g{H, (const bf16*)(ws + WS_WOAB), 1024, 1024, 1024}; pg8::Order<1> S{4, G, bx};
        EpiMerge E{(bf16*)(ws + WS_M1b), (const unsigned char*)(ws + WS_G)};
        pg8::gemm_phase(lds, g, S, E, TID());
    }
    }
#endif
    GRID_BAR();
    asm volatile("; PHASE_MARK 6");
#if !defined(ONLY) || ONLY == 6
    for (int rep_ = 0; rep_ < REPS(6); ++rep_) { if (rep_) GRID_BAR();
    {
        pg8::Gemm g{(const bf16*)(ws + WS_M1b), (const bf16*)(ws + WS_WOUT), 1024, 1024, 1024}; pg8::Order<1> S{4, G, bx};
        EpiOutSsq E{(bf16*)(ws + WS_AL), (float*)(ws + WS_SSQ_16)};
        pg8::gemm_phase(lds, g, S, E, TID());
    }
    }
#endif
#ifdef XP5
    {
        pg8::Gemm g{H, (const bf16*)(ws + WS_WOAB), 1024, 1024, 1024}; pg8::Order<1> S{4, G, bx};
        EpiMergeX<XP5> E{(bf16*)(ws + WS_F), (const unsigned char*)(ws + WS_G)};
        pg8::gemm_phase(lds, g, S, E, TID());
    }
#endif
#ifdef XP6
    {
        pg8::Gemm g{(const bf16*)(ws + WS_M1b), (const bf16*)(ws + WS_WOUT), 1024, 1024, 1024}; pg8::Order<1> S{4, G, bx};
#if XP6 == 2
        EpiNull E{(float*)(ws + WS_F)};
#elif XP6 == 3
        EpiStoreOnly E{(bf16*)(ws + WS_F)};
#elif XP6 == 4
        EpiSsqOnly E{(float*)(ws + WS_F) + 20 * 1024 * 1024};
#else
        EpiOutSsq E{(bf16*)(ws + WS_F), (float*)(ws + WS_F) + 20 * 1024 * 1024};
#endif
        pg8::gemm_phase(lds, g, S, E, TID());
    }
#endif
    GRID_BAR();
    asm volatile("; PHASE_MARK 7");
#if !defined(ONLY) || ONLY == 7
    for (int rep_ = 0; rep_ < REPS(7); ++rep_) { if (rep_) GRID_BAR();
    { int tid = TID(); asm volatile("" : "+v"(tid)); const int lane = tid & 63, wave = __builtin_amdgcn_readfirstlane(tid >> 6); p7_resid_norm(args, lds, vcu, G, tid, lane, wave); }
    }
#endif
    GRID_BAR();
    asm volatile("; PHASE_MARK 8");
#if !defined(ONLY) || ONLY == 8
    for (int rep_ = 0; rep_ < REPS(8); ++rep_) { if (rep_) GRID_BAR();
    {
        pg8::Gemm g{H, (const bf16*)(ws + WS_WUP), 1024, 1024, 1024}; pg8::Order<1> S{22, G, bx};
        EpiUp E{(bf16*)(ws + WS_ACT), (float*)(ws + WS_SB), args.in[I_CONVW], args.in[I_CONVB]};
        pg8::gemm_phase(lds, g, S, E, TID(), odd_cu * STG8);
    }
    }
#endif
    GRID_BAR();
    asm volatile("; PHASE_MARK 9");
#if !defined(ONLY) || ONLY == 9
    for (int rep_ = 0; rep_ < REPS(9); ++rep_) { if (rep_) GRID_BAR();
    { int tid = TID(); asm volatile("" : "+v"(tid)); const int lane = tid & 63, wave = __builtin_amdgcn_readfirstlane(tid >> 6); p9_conv_fix(args, vcu, G, lane, wave); }
    }
#endif
    GRID_BAR();
    asm volatile("; PHASE_MARK 10");
#if !defined(ONLY) || ONLY == 10
    for (int rep_ = 0; rep_ < REPS(10); ++rep_) { if (rep_) GRID_BAR();
    {
        pg8::Gemm g{(const bf16*)(ws + WS_ACT), (const bf16*)(ws + WS_WDN), DFF, DFF, DFF}; pg8::Order<1> S{4, G, bx};
        EpiOutSsq E{(bf16*)(ws + WS_F), (float*)(ws + WS_SSQ_16)};
        pg8::gemm_phase(lds, g, S, E, TID());
    }
    }
#endif
    GRID_BAR();
    asm volatile("; PHASE_MARK 11");
#ifdef DEBUG_FFN
    { int tid = TID(); asm volatile("" : "+v"(tid)); const int lane = tid & 63, wave = __builtin_amdgcn_readfirstlane(tid >> 6); dbg_check_act(args, vcu, G, lane, wave); }
    GRID_BAR();
#endif
#if !defined(ONLY) || ONLY == 11
    for (int rep_ = 0; rep_ < REPS(11); ++rep_) { if (rep_) GRID_BAR();
    { int tid = TID(); asm volatile("" : "+v"(tid)); const int lane = tid & 63, wave = __builtin_amdgcn_readfirstlane(tid >> 6); p11_final(args, lds, vcu, G, tid, lane, wave); }
    }
#endif
#ifdef DEBUG_FFN
    if (bx == 0 && TID() == 0) { unsigned* ctl = (unsigned*)(ws + WS_CTL); const unsigned mask = __hip_atomic_load(ctl + DBG_W, __ATOMIC_RELAXED, __HIP_MEMORY_SCOPE_AGENT), md = __hip_atomic_load(ctl + DBG_W + 1, __ATOMIC_RELAXED, __HIP_MEMORY_SCOPE_AGENT);
        float mant = 10.f + fminf(89.f, (float)md * 0.01f); float v = mant; for (unsigned i = 0; i < 4 + mask; ++i) v *= 10.f; args.out[0] = v; }
#endif
}

extern "C" void kernel_launch(void* const* d_in, const int* in_sizes, int n_in, void* d_out, int out_size, void* d_ws, size_t ws_size, hipStream_t stream) {
    static int grid = 0;
    if (grid == 0) {
        if (n_in != 24 || out_size != RL * DM || ws_size < 452 * MiB) { fprintf(stderr, "kernel_launch: unexpected shapes (n_in %d out %d ws %zu)\n", n_in, out_size, ws_size); grid = -1; return; }
        int dev = 0, cus = 0;
        if (hipGetDevice(&dev) != hipSuccess || hipDeviceGetAttribute(&cus, hipDeviceAttributeMultiprocessorCount, dev) != hipSuccess) { grid = -1; return; }
        if (hipFuncSetAttribute((const void*)fwd_kernel, hipFuncAttributeMaxDynamicSharedMemorySize, LDS_BYTES) != hipSuccess) { fprintf(stderr, "kernel_launch: hipFuncSetAttribute failed\n"); grid = -1; return; }
        int per_cu = 0;
        if (hipOccupancyMaxActiveBlocksPerMultiprocessor(&per_cu, (const void*)fwd_kernel, NWAVES * 64, LDS_BYTES) != hipSuccess || per_cu < 1) fprintf(stderr, "kernel_launch: occupancy query says %d\n", per_cu);
        (void)hipGetLastError();
        grid = cus;
    }
    if (grid < 0) return;
    if (hipMemsetAsync((char*)d_ws + WS_CTL, 0, CTL_ZERO_BYTES, stream) != hipSuccess) return;
    Args a{};
    for (int i = 0; i < 24; ++i) a.in[i] = (const float*)d_in[i];
    a.out = (float*)d_out; a.ws = (unsigned char*)d_ws;
    hipLaunchKernelGGL(fwd_kernel, dim3(grid), dim3(NWAVES * 64), LDS_BYTES, stream, a);
}
```

```cpp
#include <hip/hip_runtime.h>
#include <hip/hip_bf16.h>
#include <cstdio>
#include <cstdint>
#include <cmath>
namespace pg8 {
#define PG8_LAS __attribute__((address_space(3)))
typedef unsigned short bf16_t;
typedef short bf16x8 __attribute__((ext_vector_type(8)));
typedef float f32x4 __attribute__((ext_vector_type(4)));
typedef unsigned u32x4 __attribute__((ext_vector_type(4)));
typedef unsigned u32x2 __attribute__((ext_vector_type(2)));
constexpr int BM = 256, BK = 64, HALF = 128, HTB = HALF * BK * 2, STAGE_BYTES = 8 * HTB, NXCD = 8, WGM = 8;

__host__ __device__ __forceinline__ int lds_byte(int r, int c) { const int st = (r >> 4) * 2 + (c >> 5), rr = r & 15, cc = c & 31, ob = rr * 64 + cc * 2; return st * 1024 + (ob ^ (((ob >> 9) & 1) << 5)); }
__host__ __device__ __forceinline__ void stage_rc(int b, int& R, int& C) { const int st = b / 1024, sb = b % 1024, swz = sb ^ (((sb >> 9) & 1) << 5); R = (st >> 1) * 16 + swz / 64; C = (st & 1) * 32 + (swz % 64) / 2; }

struct Unit { int pm, pn; };
struct Gemm { const bf16_t* A; const bf16_t* Bt; int lda, ldb, K; };

__device__ __forceinline__ bool static_unit(int nM, int nN, long L, Unit& u) {
    const int nwg = nM * nN; if (L >= nwg) return false;
    int wgid = (int)L; { const int q = nwg / NXCD, r = nwg % NXCD, xcd = wgid % NXCD, off = wgid / NXCD; wgid = (xcd < r ? xcd * (q + 1) : r * (q + 1) + (xcd - r) * q) + off; }
    const int nig = WGM * nN, gid = wgid / nig, fm = gid * WGM, gsz = (nM - fm) < WGM ? (nM - fm) : WGM;
    u.pm = fm + ((wgid % nig) % gsz); u.pn = (wgid % nig) / gsz; return true;
}
template <int MODE> struct Order {
    int nN, G, c;
    __device__ __forceinline__ bool next(int i, Unit& u) const {
        const long L = (long)i * G + c;
        if (MODE == 3) {
            if (static_unit(136, 4, L, u)) { u.pm += 136; u.pn += 3; return true; }
            if (!static_unit(128, 3, L - 136 * 4, u)) return false; u.pm = (u.pm >> 4) * 17 + 1 + (u.pm & 15); return true; }
        if (MODE == 0) return static_unit(136, nN, L, u);
        if (MODE == 1) { if (!static_unit(128, nN, L, u)) return false; u.pm = (u.pm >> 4) * 17 + 1 + (u.pm & 15); return true; }
        if (static_unit(128, 13, L, u)) { u.pm = (u.pm >> 4) * 17 + 1 + (u.pm & 15); return true; }
        const long e = L - 128 * 13; if (e >= 16) return false;
        u.pm = (int)(e >> 1) * 17; u.pn = 1 + (int)(e & 1); return true;
    }
};

template <class Epi, class Sched>
__device__ __forceinline__ void gemm_phase(PG8_LAS unsigned char* lds, const Gemm g, const Sched& S, const Epi& E, int tid_in, int stagger_ticks = 0) {
    int tid_ = tid_in; asm volatile("" : "+v"(tid_));
    const int tid = tid_, wid = __builtin_amdgcn_readfirstlane(tid >> 6), lane = tid & 63, wr = wid >> 2, wc = wid & 3, fr = lane & 15, fq = lane >> 4;
    const int K = g.K, nt = K / BK;
    unsigned voffA[2], voffB[2];
#pragma unroll
    for (int i = 0; i < 2; ++i) { int R, C; stage_rc(tid * 16 + i * 8192, R, C);
        voffA[i] = (unsigned)(R * g.lda + C) * 2u; voffB[i] = (unsigned)(R * g.ldb + C) * 2u; }
    const size_t kstep = (size_t)(BK * 2);
    const size_t hstepA = (size_t)HALF * g.lda * 2, hstepB = (size_t)HALF * g.ldb * 2;
    const size_t tstepA = 2 * hstepA, tstepB = 2 * hstepB;
    const unsigned ldsw = (unsigned)wid * 1024u;
    const int aoff = lds_byte(wr * 64 + fr, fq * 8), boff = lds_byte(wc * 32 + fr, fq * 8);
#define PG8_SA(b, h) (((b) * 2 + (h)) * HTB)
#define PG8_SB(b, h) ((4 + (b) * 2 + (h)) * HTB)
#define PG8_STAGE(bufoff, gbase, voff) do { _Pragma("unroll") for (int _i = 0; _i < 2; ++_i) \
        __builtin_amdgcn_global_load_lds((const unsigned*)((const char*)(gbase) + (voff)[_i]), (PG8_LAS unsigned*)(lds + (bufoff) + ldsw + _i * 8192), 16, 0, 0); } while (0)
#define PG8_LDA(dst, b, h) do { _Pragma("unroll") for (int m = 0; m < 4; ++m) _Pragma("unroll") for (int k = 0; k < 2; ++k) dst[m][k] = *(const PG8_LAS bf16x8*)(lds + PG8_SA(b, h) + aoff + m * 2048 + k * 1024); } while (0)
#define PG8_LDB(dst, b, h) do { _Pragma("unroll") for (int n = 0; n < 2; ++n) _Pragma("unroll") for (int k = 0; k < 2; ++k) dst[n][k] = *(const PG8_LAS bf16x8*)(lds + PG8_SB(b, h) + boff + n * 2048 + k * 1024); } while (0)
#define PG8_MMA(ai, bj, At, Bt) do { __builtin_amdgcn_s_setprio(1); _Pragma("unroll") for (int m = 0; m < 4; ++m) _Pragma("unroll") for (int n = 0; n < 2; ++n) _Pragma("unroll") for (int k = 0; k < 2; ++k) \
        acc[ai][bj][m][n] = __builtin_amdgcn_mfma_f32_16x16x32_bf16(Bt[n][k], At[m][k], acc[ai][bj][m][n], 0, 0, 0); __builtin_amdgcn_s_setprio(0); } while (0)
#define PG8_WAIT_V(n) asm volatile("s_waitcnt vmcnt(" #n ")" ::: "memory")
#define PG8_WAIT_L(n) asm volatile("s_waitcnt lgkmcnt(" #n ")" ::: "memory")
#define PG8_BAR __builtin_amdgcn_s_barrier()
#define PG8_SCHED __builtin_amdgcn_sched_barrier(0)
    Unit cur, nxt; int ui = 0;
    if (!S.next(0, cur)) return;
    if (stagger_ticks > 0) { const unsigned long long t0_ = __builtin_amdgcn_s_memrealtime(); while (__builtin_amdgcn_s_memrealtime() - t0_ < (unsigned long long)stagger_ticks) __builtin_amdgcn_s_sleep(8); }
    f32x4 acc[2][2][4][2];
#pragma unroll
    for (int a = 0; a < 2; ++a)
#pragma unroll
        for (int b = 0; b < 2; ++b)
#pragma unroll
            for (int m = 0; m < 4; ++m)
#pragma unroll
                for (int n = 0; n < 2; ++n) acc[a][b][m][n] = (f32x4){0.f, 0.f, 0.f, 0.f};
    bf16x8 At[4][2], B0[2][2], B1[2][2];
    const char* cA = (const char*)g.A + (size_t)cur.pm * tstepA; const char* cB = (const char*)g.Bt + (size_t)cur.pn * tstepB;
    PG8_STAGE(PG8_SB(0, 0), cB, voffB); PG8_STAGE(PG8_SB(0, 1), cB + hstepB, voffB); PG8_STAGE(PG8_SA(0, 0), cA, voffA); PG8_STAGE(PG8_SA(0, 1), cA + hstepA, voffA);
    if (wr == 1) PG8_BAR;
    PG8_WAIT_V(2); PG8_BAR;
    PG8_STAGE(PG8_SB(1, 0), cB + kstep, voffB); PG8_STAGE(PG8_SA(1, 0), cA + kstep, voffA); PG8_STAGE(PG8_SB(1, 1), cB + hstepB + kstep, voffB);
    PG8_WAIT_V(6); PG8_BAR;
    for (;;) {
        const bool has_next = S.next(ui + 1, nxt);
        const char* nA = has_next ? (const char*)g.A + (size_t)nxt.pm * tstepA : cA; const char* nB = has_next ? (const char*)g.Bt + (size_t)nxt.pn * tstepB : cB;
        for (int t = 0; t < nt; t += 2) {
            if constexpr (Epi::MID_T > 0) { if (t == Epi::MID_T) { int fr_ = fr, fq_ = fq; asm volatile("" : "+v"(fr_), "+v"(fq_)); E.mid(acc, cur, wr, wc, fr_, fq_); } }
            const bool last = (t == nt - 2);
            const char* a1 = cA + (size_t)(t + 1) * kstep;
            const char* a2 = last ? nA : cA + (size_t)(t + 2) * kstep; const char* b2 = last ? nB : cB + (size_t)(t + 2) * kstep;
            const char* a3 = a2 + kstep; const char* b3 = b2 + kstep;
            PG8_LDB(B0, 0, 0); PG8_LDB(B1, 0, 1); PG8_SCHED; PG8_LDA(At, 0, 0); PG8_STAGE(PG8_SA(1, 1), a1 + hstepA, voffA);
            PG8_WAIT_V(8); PG8_WAIT_L(0); PG8_BAR; PG8_MMA(0, 0, At, B0); PG8_MMA(0, 1, At, B1); PG8_BAR; PG8_SCHED;
            PG8_LDA(At, 0, 1); PG8_STAGE(PG8_SB(0, 0), b2, voffB); PG8_STAGE(PG8_SB(0, 1), b2 + hstepB, voffB); PG8_STAGE(PG8_SA(0, 0), a2, voffA);
            PG8_WAIT_V(8); PG8_WAIT_L(0); PG8_BAR; PG8_MMA(1, 0, At, B0); PG8_MMA(1, 1, At, B1); PG8_BAR; PG8_SCHED;
            PG8_LDB(B0, 1, 0); PG8_LDB(B1, 1, 1); PG8_SCHED; PG8_LDA(At, 1, 0); PG8_STAGE(PG8_SA(0, 1), a2 + hstepA, voffA);
            PG8_WAIT_V(8); PG8_WAIT_L(0); PG8_BAR; PG8_MMA(0, 0, At, B0); PG8_MMA(0, 1, At, B1); PG8_BAR; PG8_SCHED;
            PG8_LDA(At, 1, 1); PG8_STAGE(PG8_SB(1, 0), b3, voffB); PG8_STAGE(PG8_SB(1, 1), b3 + hstepB, voffB); PG8_STAGE(PG8_SA(1, 0), a3, voffA);
            PG8_WAIT_V(8); PG8_WAIT_L(0); PG8_BAR; PG8_MMA(1, 0, At, B0); PG8_MMA(1, 1, At, B1); PG8_BAR; PG8_SCHED;
        }
        if (wr == 0) PG8_BAR;
        { int fr_ = fr, fq_ = fq; asm volatile("" : "+v"(fr_), "+v"(fq_));
          E(acc, cur, wr, wc, fr_, fq_); }
        if (!has_next) break;
#pragma unroll
        for (int a = 0; a < 2; ++a)
#pragma unroll
            for (int b = 0; b < 2; ++b)
#pragma unroll
                for (int m = 0; m < 4; ++m)
#pragma unroll
                    for (int n = 0; n < 2; ++n) acc[a][b][m][n] = (f32x4){0.f, 0.f, 0.f, 0.f};
        cur = nxt; cA = nA; cB = nB; ++ui;
        if (wr == 1) PG8_BAR;
    }
    PG8_WAIT_V(0);
    PG8_BAR;
#undef PG8_SA
#undef PG8_SB
#undef PG8_STAGE
#undef PG8_LDA
#undef PG8_LDB
#undef PG8_MMA
#undef PG8_WAIT_V
#undef PG8_WAIT_L
#undef PG8_BAR
#undef PG8_SCHED
}
}
namespace att {
typedef unsigned short bf16_t;
using bf16x8 = __attribute__((ext_vector_type(8))) short;
using s16x4  = __attribute__((ext_vector_type(4))) short;
using f32x16 = __attribute__((ext_vector_type(16))) float;
using u32x4  = __attribute__((ext_vector_type(4))) unsigned;
constexpr int NW = 8, QBLK = 32, KVBLK = 64;
constexpr int SHM_V = 64 * 64 * 2, SHM_K = 64 * 128 * 2, NVB = 4, NKB = 3;
constexpr int OFF_V = 0, OFF_K = NVB * SHM_V, OFF_WS = OFF_K + NKB * SHM_K, OFF_OST = OFF_WS + NW * 64 * 4, ATT_LDS = OFF_OST + NW * 4096;
#define KSWZ(row, colB) ((row) * 256 + ((colB) ^ (((row) & 7) << 4)))
#define SBAR() __builtin_amdgcn_sched_barrier(0)
__device__ __forceinline__ int crow(int r, int hi) { return (r & 3) + 8 * (r >> 2) + 4 * hi; }
typedef float f32x2_t __attribute__((ext_vector_type(2))); typedef __bf16 bf16x2_t __attribute__((ext_vector_type(2)));
__device__ __forceinline__ unsigned cvtpk(float lo, float hi) { f32x2_t v = {lo, hi}; bf16x2_t b = __builtin_convertvector(v, bf16x2_t); return __builtin_bit_cast(unsigned, b); }

template <int SC1000000  > struct Dummy {};

template <int VAR> __device__ __forceinline__ void partialSM(f32x16& p0, f32x16& p1, float& m_reg, float& mn, float& alpha, const float C, const float THRS) {
  float pmax = p0[0];
#pragma unroll
  for (int r = 1; r < 16; ++r) pmax = fmaxf(pmax, p0[r]);
#pragma unroll
  for (int r = 0; r < 16; ++r) pmax = fmaxf(pmax, p1[r]);
  { auto rr = __builtin_amdgcn_permlane32_swap(__float_as_uint(pmax), __float_as_uint(pmax), false, false);
    pmax = fmaxf(__uint_as_float(rr[0]), __uint_as_float(rr[1])); }
  if (__builtin_expect(__all(pmax - m_reg <= THRS), 1)) { mn = m_reg; alpha = 1.f; }
  else { mn = fmaxf(m_reg, pmax); alpha = __builtin_amdgcn_exp2f((m_reg - mn) * C); m_reg = mn; }
  float mnC = -mn * C;
#pragma unroll
  for (int r = 0; r < 16; ++r) p0[r] = fmaf(p0[r], C, mnC);
#pragma unroll
  for (int r = 0; r < 16; ++r) p1[r] = fmaf(p1[r], C, mnC);
#pragma unroll
  for (int r = 0; r < 16; ++r) p0[r] = (VAR & 1) ? p0[r] * 0.001f : __builtin_amdgcn_exp2f(p0[r]);
}
template <int VAR> __device__ __forceinline__ void finishSM(f32x16& p0, f32x16& p1, float alpha, float& l_reg, bf16x8& pa0, bf16x8& pa1, bf16x8& pa2, bf16x8& pa3) {
#pragma unroll
  for (int r = 0; r < 16; ++r) p1[r] = (VAR & 1) ? p1[r] * 0.001f : __builtin_amdgcn_exp2f(p1[r]);
  float ps = 0;
#pragma unroll
  for (int r = 0; r < 16; ++r) ps += p0[r];
#pragma unroll
  for (int r = 0; r < 16; ++r) ps += p1[r];
  { auto rr = __builtin_amdgcn_permlane32_swap(__float_as_uint(ps), __float_as_uint(ps), false, false);
    ps = __uint_as_float(rr[0]) + __uint_as_float(rr[1]); }
  l_reg = l_reg * alpha + ps;
#define PK4(P, BASE, OUT) do { unsigned a0 = cvtpk(P[BASE + 0], P[BASE + 1]), a1 = cvtpk(P[BASE + 2], P[BASE + 3]);   \
    unsigned b0 = cvtpk(P[BASE + 4], P[BASE + 5]), b1 = cvtpk(P[BASE + 6], P[BASE + 7]);                              \
    auto r0 = __builtin_amdgcn_permlane32_swap(a0, b0, false, false); auto r1 = __builtin_amdgcn_permlane32_swap(a1, b1, false, false); \
    u32x4 w = {r0[0], r1[0], r0[1], r1[1]}; OUT = *reinterpret_cast<bf16x8*>(&w); } while (0)
  PK4(p0, 0, pa0); PK4(p0, 8, pa1); PK4(p1, 0, pa2); PK4(p1, 8, pa3);
#undef PK4
}
template <int ND0, int VAR = 0> __device__ __forceinline__ void qkt(f32x16& p0, f32x16& p1, const char* Ks, const bf16x8* qr, int r32, int hi, const f32x16& negm) {
  p0 = negm; p1 = negm;
#pragma unroll
  for (int d0 = 0; d0 < ND0; ++d0) { int cb = (d0 * 16 + hi * 8) * 2;
    bf16x8 b0, b1;
    if (VAR & 4) { b0 = qr[d0]; b1 = qr[(d0 + 1) % ND0]; } else {
    b0 = *reinterpret_cast<const bf16x8*>(Ks + KSWZ(r32, cb));
    b1 = *reinterpret_cast<const bf16x8*>(Ks + KSWZ(32 + r32, cb)); }
    if (VAR & 16) { p0[d0] += (float)b0[0]; p1[d0] += (float)b1[1]; } else {
    p0 = __builtin_amdgcn_mfma_f32_32x32x16_bf16(b0, qr[d0], p0, 0, 0, 0);
    p1 = __builtin_amdgcn_mfma_f32_32x32x16_bf16(b1, qr[d0], p1, 0, 0, 0); } }
}
__device__ __forceinline__ int v_st(int k, int c) { const int kk = (k & ~0xC) | ((k & 4) << 1) | ((k & 8) >> 1); return ((kk >> 3) * 2 + (c >> 5)) * 512 + ((kk & 7) * 32 + (c & 31)) * 2; }
__device__ __forceinline__ int v_rd_base(int lane) { return ((lane & 3) << 3) | (((lane >> 2) & 3) << 6) | (((lane >> 4) & 1) << 5) | (((lane >> 5) & 1) << 8); }
constexpr int v_rd_off(int d0, int ks, int half) { return d0 * 512 + ks * 2048 + half * 1024; }
template <int OFF> __device__ __forceinline__ s16x4 tr_read(int vb) {
  s16x4 r; asm volatile("ds_read_b64_tr_b16 %0, %1 offset:%2" : "=&v"(r) : "v"(vb), "i"(OFF) : "memory"); return r;
}
template <int D0, int VAR = 0> __device__ __forceinline__ void pv_one(f32x16& od, int vb, bf16x8 pa0, bf16x8 pa1, bf16x8 pa2, bf16x8 pa3) {
  if (VAR & 8) {
    if (VAR & 16) { od[0] += (float)pa0[0]; od[1] += (float)pa1[0]; od[2] += (float)pa2[0]; od[3] += (float)pa3[0]; return; }
    od = __builtin_amdgcn_mfma_f32_32x32x16_bf16(pa0, pa1, od, 0, 0, 0); od = __builtin_amdgcn_mfma_f32_32x32x16_bf16(pa1, pa2, od, 0, 0, 0);
    od = __builtin_amdgcn_mfma_f32_32x32x16_bf16(pa2, pa3, od, 0, 0, 0); od = __builtin_amdgcn_mfma_f32_32x32x16_bf16(pa3, pa0, od, 0, 0, 0); return; }
  const s16x4 l0 = tr_read<v_rd_off(D0, 0, 0)>(vb), h0 = tr_read<v_rd_off(D0, 0, 1)>(vb), l1 = tr_read<v_rd_off(D0, 1, 0)>(vb), h1 = tr_read<v_rd_off(D0, 1, 1)>(vb);
  const s16x4 l2 = tr_read<v_rd_off(D0, 2, 0)>(vb), h2 = tr_read<v_rd_off(D0, 2, 1)>(vb), l3 = tr_read<v_rd_off(D0, 3, 0)>(vb), h3 = tr_read<v_rd_off(D0, 3, 1)>(vb);
  asm volatile("s_waitcnt lgkmcnt(0)" ::: "memory"); SBAR();
#define PK(L, H) (bf16x8){L[0], L[1], L[2], L[3], H[0], H[1], H[2], H[3]}
  od = __builtin_amdgcn_mfma_f32_32x32x16_bf16(pa0, PK(l0, h0), od, 0, 0, 0);
  od = __builtin_amdgcn_mfma_f32_32x32x16_bf16(pa1, PK(l1, h1), od, 0, 0, 0);
  od = __builtin_amdgcn_mfma_f32_32x32x16_bf16(pa2, PK(l2, h2), od, 0, 0, 0);
  od = __builtin_amdgcn_mfma_f32_32x32x16_bf16(pa3, PK(l3, h3), od, 0, 0, 0);
#undef PK
}
template <int VAR = 0> __device__ __forceinline__ void pv_d0(f32x16* o, int vb, bf16x8 pa0, bf16x8 pa1, bf16x8 pa2, bf16x8 pa3) {
  pv_one<0, VAR>(o[0], vb, pa0, pa1, pa2, pa3); pv_one<1, VAR>(o[1], vb, pa0, pa1, pa2, pa3);
}

struct AttnIO {
  const bf16_t* Q1;
  const bf16_t* Q2;
  const bf16_t* K1;
  const bf16_t* K2;
  const bf16_t* V;
  bf16_t* O;
};
template <bool SWA, int VAR = 0>
__device__ __forceinline__ void attn_unit(const AttnIO io, const int q0  , const float sink, char* lds, int tid_in) {
  constexpr int ND0 = SWA ? 4 : 6;
  constexpr int LDQ1 = 512, LDQ2 = 256, LDK1 = SWA ? 128 : 512, LDK2 = 32, LDV = SWA ? 128 : 512, LDO = 1024;
  constexpr float SCALE = SWA ? 0.125f : 0.10206207261596575f;
  int tid_ = tid_in; asm volatile("" : "+v"(tid_));
  const int tid = tid_, wid = tid >> 6, lane = tid & 63, r32 = lane & 31, hi = lane >> 5;
  char* V_lds = lds + OFF_V; char* K_lds = lds + OFF_K;
  float* ws = (float*)(lds + OFF_WS) + wid * 64; float* li_l = ws; float* al_l = ws + 32;
  float l_reg = 0; f32x16 o[2] = {}; bf16x8 qr[ND0];
  {
    const bf16_t* Qw = io.Q1 + (long)(wid * QBLK + r32) * LDQ1 + hi * 8;
#pragma unroll
    for (int d0 = 0; d0 < 4; ++d0) qr[d0] = *reinterpret_cast<const bf16x8*>(Qw + d0 * 16);
    if constexpr (!SWA) {
      const bf16_t* Qw2 = io.Q2 + (long)(wid * QBLK + r32) * LDQ2 + hi * 8;
#pragma unroll
      for (int d0 = 0; d0 < 2; ++d0) qr[4 + d0] = *reinterpret_cast<const bf16x8*>(Qw2 + d0 * 16);
    }
  }
  const int sr = tid >> 3, sc = (tid & 7) * 8, vst = v_st(sr, sc), kst = KSWZ(sr, sc * 2);
  const int sr2 = (tid & 255) >> 2, sc2 = (tid & 3) * 8, kst2 = KSWZ(sr2, (64 + sc2) * 2);
  const int vb0 = (int)(uintptr_t)V_lds + v_rd_base(lane);
  int NT, jlo = 0;
  if constexpr (SWA) { jlo = (q0 == 0) ? 2 : 0; NT = 4 + 8 - jlo - ((q0 == 4096 - 256) ? 2 : 0); } else NT = 68;
#define KEY0(t) (SWA ? ((t) < 4 ? (t) * 64 : 256 + q0 - 128 + ((t) - 4 + jlo) * 64) : (t) * 64)
  struct { bf16x8 v, k, k2; } sr_;
#define SLOAD(t) do { if (VAR & 2) break; const long k0_ = KEY0(t); sr_.v = *reinterpret_cast<const bf16x8*>(io.V + (k0_ + sr) * LDV + sc); \
    sr_.k = *reinterpret_cast<const bf16x8*>(io.K1 + (k0_ + sr) * LDK1 + sc); \
    if constexpr (!SWA) sr_.k2 = *reinterpret_cast<const bf16x8*>(io.K2 + (k0_ + sr2) * LDK2 + sc2); } while (0)
#define SWRITE(kb_, vb_) do { if (VAR & 2) break; *(bf16x8*)(V_lds + (vb_) * SHM_V + vst) = sr_.v; *(bf16x8*)(K_lds + (kb_) * SHM_K + kst) = sr_.k; \
    if constexpr (!SWA) { if (tid < 256) *(bf16x8*)(K_lds + (kb_) * SHM_K + kst2) = sr_.k2; } } while (0)
#define RESC(a) do { if (__any((a) < 1.f)) { if (hi == 0) al_l[r32] = (a); asm volatile("s_waitcnt lgkmcnt(0)" ::: "memory"); \
    _Pragma("unroll") for (int d = 0; d < 2; ++d) _Pragma("unroll") for (int r = 0; r < 16; ++r) o[d][r] *= al_l[crow(r, hi)]; } } while (0)
#define MASK(P0, P1, t) do { if constexpr (SWA) { if ((t) >= 4) { const int base_ = -128 + ((t) - 4 + jlo) * 64 - wid * QBLK - r32 + 4 * hi; \
    _Pragma("unroll") for (int r = 0; r < 16; ++r) { const int d_ = base_ + (r & 3) + 8 * (r >> 2); \
      if (d_ > 128 || d_ < -128) P0[r] = -INFINITY; if (d_ + 32 > 128 || d_ + 32 < -128) P1[r] = -INFINITY; } } } } while (0)
  f32x16 p0, p1; float al; bf16x8 pa0, pa1, pa2, pa3;
  const int half = __builtin_amdgcn_readfirstlane(wid >> 2);
  f32x16 negm = f32x16{}; asm volatile("" : "+v"(negm));
  float mref = 0.f; constexpr float THR2 = 8.f;
#define SOFTMAX(t, FIRST) do { MASK(p0, p1, t); \
    float pmax_ = p0[0]; _Pragma("unroll") for (int r = 1; r < 16; ++r) pmax_ = fmaxf(pmax_, p0[r]); _Pragma("unroll") for (int r = 0; r < 16; ++r) pmax_ = fmaxf(pmax_, p1[r]); \
    { auto rr = __builtin_amdgcn_permlane32_swap(__float_as_uint(pmax_), __float_as_uint(pmax_), false, false); pmax_ = fmaxf(__uint_as_float(rr[0]), __uint_as_float(rr[1])); } \
    al = 1.f; \
    if ((FIRST) || !__all(pmax_ <= THR2)) { const float dl_ = (FIRST) ? pmax_ : fmaxf(pmax_, 0.f); mref += dl_; al = (FIRST) ? 1.f : __builtin_amdgcn_exp2f(-dl_); \
      _Pragma("unroll") for (int r = 0; r < 16; ++r) { p0[r] -= dl_; p1[r] -= dl_; } \
      _Pragma("unroll") for (int r = 0; r < 16; ++r) negm[r] = -mref; asm volatile("" : "+v"(negm)); \
      if (!(FIRST)) RESC(al); } \
    _Pragma("unroll") for (int r = 0; r < 16; ++r) p0[r] = (VAR & 1) ? p0[r] * 0.001f : __builtin_amdgcn_exp2f(p0[r]); \
    finishSM<VAR>(p0, p1, al, l_reg, pa0, pa1, pa2, pa3); } while (0)
  typedef __attribute__((address_space(3))) const char* lcp; typedef short v4i16_t __attribute__((ext_vector_type(4)));
  const lcp K3 = (lcp)K_lds; const lcp V3 = (lcp)V_lds + v_rd_base(lane);
  bf16x8 kf[2 * ND0]; s16x4 vlo[8], vhi[8];
#define LDK(kb_) do { _Pragma("unroll") for (int d0 = 0; d0 < ND0; ++d0) { const int cb = (d0 * 16 + hi * 8) * 2; \
    kf[2 * d0] = *(const __attribute__((address_space(3))) bf16x8*)(K3 + (kb_) * SHM_K + KSWZ(r32, cb)); \
    kf[2 * d0 + 1] = *(const __attribute__((address_space(3))) bf16x8*)(K3 + (kb_) * SHM_K + KSWZ(32 + r32, cb)); } } while (0)
#define VTR(p_) __builtin_bit_cast(s16x4, __builtin_amdgcn_ds_read_tr16_b64_v4i16((__attribute__((address_space(3))) v4i16_t*)(p_)))
#define LDV(vb_) do { _Pragma("unroll") for (int d0 = 0; d0 < 2; ++d0) _Pragma("unroll") for (int ks = 0; ks < 4; ++ks) { \
    vlo[d0 * 4 + ks] = VTR(V3 + (vb_) * SHM_V + v_rd_off(d0, ks, 0)); vhi[d0 * 4 + ks] = VTR(V3 + (vb_) * SHM_V + v_rd_off(d0, ks, 1)); } } while (0)
#define VFR(i) (bf16x8){vlo[i][0], vlo[i][1], vlo[i][2], vlo[i][3], vhi[i][0], vhi[i][1], vhi[i][2], vhi[i][3]}
#define MM(acc, a, b) acc = __builtin_amdgcn_mfma_f32_32x32x16_bf16(a, b, acc, 0, 0, 0)
#define MSEG(DO_PV, DO_QK) do { __builtin_amdgcn_s_setprio(1); \
    if (DO_QK) { p0 = negm; p1 = negm; } \
    if (DO_QK) { MM(p0, kf[0], qr[0]); MM(p1, kf[1], qr[0]); } if (DO_PV) { MM(o[0], pa0, VFR(0)); MM(o[1], pa0, VFR(4)); } \
    if (DO_QK) { MM(p0, kf[2], qr[1]); MM(p1, kf[3], qr[1]); } if (DO_PV) { MM(o[0], pa1, VFR(1)); MM(o[1], pa1, VFR(5)); } \
    if (DO_QK) { MM(p0, kf[4], qr[2]); MM(p1, kf[5], qr[2]); } if (DO_PV) { MM(o[0], pa2, VFR(2)); MM(o[1], pa2, VFR(6)); } \
    if (DO_QK) { MM(p0, kf[6], qr[3]); MM(p1, kf[7], qr[3]); } if (DO_PV) { MM(o[0], pa3, VFR(3)); MM(o[1], pa3, VFR(7)); } \
    if constexpr (ND0 > 4) { if (DO_QK) { MM(p0, kf[8], qr[4]); MM(p1, kf[9], qr[4]); MM(p0, kf[10], qr[5]); MM(p1, kf[11], qr[5]); } } \
    __builtin_amdgcn_s_setprio(0); } while (0)
  SLOAD(0); asm volatile("s_waitcnt vmcnt(0)" ::: "memory"); SWRITE(0, 0); SLOAD(1); asm volatile("s_waitcnt vmcnt(0)" ::: "memory"); SWRITE(1, 1); if (2 < NT) SLOAD(2);
  __syncthreads();
  if (half) __syncthreads();
  int kc = 0, vp = 3;
  LDK(0); SBAR(); MSEG(false, true);
  __syncthreads();
  SOFTMAX(0, true); if (2 < NT) SWRITE(2, 2); if (3 < NT) SLOAD(3);
  __syncthreads();
  for (int t = 1; t < NT; ++t) {
    kc = (kc == NKB - 1) ? 0 : kc + 1; vp = (vp == NVB - 1) ? 0 : vp + 1;
    SBAR(); LDK(kc); LDV(vp); SBAR(); MSEG(true, true); SBAR();
    __syncthreads();
    SOFTMAX(t, false);
    if (t + 2 < NT) { int k2 = kc + 2; if (k2 >= NKB) k2 -= NKB; int v2 = vp + 3; if (v2 >= NVB) v2 -= NVB; SWRITE(k2, v2); }
    if (t + 3 < NT) SLOAD(t + 3);
    __syncthreads();
  }
  vp = (vp == NVB - 1) ? 0 : vp + 1;
  LDV(vp); SBAR(); MSEG(true, false);
  if (!half) __syncthreads();
#undef MSEG
#undef MM
#undef VFR
#undef LDV
#undef VTR
#undef LDK
#undef SOFTMAX
  if constexpr (SWA) l_reg += __builtin_amdgcn_exp2f(sink * 1.4426950408889634f - mref);
  if (hi == 0) li_l[r32] = l_reg; asm volatile("s_waitcnt lgkmcnt(0)" ::: "memory");
  float rli[16];
#pragma unroll
  for (int r = 0; r < 16; ++r) rli[r] = __builtin_amdgcn_rcpf(li_l[crow(r, hi)]);
  { bf16_t* stg = (bf16_t*)(lds + OFF_OST) + wid * 2048;
#pragma unroll
    for (int r = 0; r < 16; ++r) { const int orow = crow(r, hi);
#pragma unroll
      for (int d0 = 0; d0 < 2; ++d0) stg[orow * 64 + d0 * 32 + r32] = (bf16_t)(cvtpk(o[d0][r] * rli[r], 0.f) & 0xffffu); }
    asm volatile("s_waitcnt lgkmcnt(0)" ::: "memory");
    bf16_t* Ow = io.O + (long)(wid * QBLK) * LDO;
#pragma unroll
    for (int i = 0; i < 4; ++i) { const int row = i * 8 + (lane >> 3), ch = lane & 7; const u32x4 v = *(const u32x4*)(stg + row * 64 + ch * 8); *(u32x4*)(Ow + (long)row * LDO + ch * 8) = v; } }
  __syncthreads();
#undef SLOAD
#undef SWRITE
#undef RESC
#undef MASK
#undef KEY0
}
#undef KSWZ
#undef SBAR
}
constexpr int NWAVES = 8;
constexpr int DM = 1024, NB = 8, SEQ = 4096, CTX = 256, TPB = SEQ + CTX  , RT = NB * TPB  , RL = NB * SEQ  ;
constexpr int DIN = 3232, DINP = 3328, DFF = 2816, DUP = 5632;
constexpr float EPS = 1e-6f;
constexpr size_t MiB = 1u << 20;
constexpr size_t WS_CTL = 0, CTL_ZERO_BYTES = 64 * 1024;
constexpr size_t WS_ROPE_S = 64 * 1024;
constexpr size_t WS_ROPE_M = WS_ROPE_S + 64 * 16 * 8;
constexpr size_t WS_MODF = 128 * 1024;
constexpr size_t WS_SSQ_Q = 512 * 1024;
constexpr size_t WS_SSQ_KV = WS_SSQ_Q + (size_t)RT * 16;
constexpr size_t WS_SSQ_16 = WS_SSQ_KV + (size_t)RT * 16;
constexpr size_t WS_MODP = 4 * MiB;
constexpr size_t WS_WIN = 8 * MiB;
constexpr size_t WS_WQ = WS_WIN + (size_t)DINP * 1024 * 2;
constexpr size_t WS_WKV = WS_WQ + 768 * 256 * 2;
constexpr size_t WS_WOAB = WS_WKV + 1024 * 256 * 2;
constexpr size_t WS_WOUT = WS_WOAB + 1024 * 1024 * 2;
constexpr size_t WS_WUP = WS_WOUT + 1024 * 1024 * 2;
constexpr size_t WS_WDN = WS_WUP + (size_t)DUP * 1024 * 2;
static_assert(WS_WDN + (size_t)1024 * DFF * 2 <= 40 * MiB, "weights");
constexpr size_t WS_H = 40 * MiB;
constexpr size_t WS_G = 108 * MiB;
constexpr size_t WS_QA = 244 * MiB, WS_KVR = 261 * MiB, WS_KR = 278 * MiB, WS_KS = 281 * MiB, WS_VS = 290 * MiB, WS_QS = 299 * MiB;
constexpr size_t WS_QN = 333 * MiB, WS_QR = 367 * MiB, WS_KN = 384 * MiB, WS_VM = 418 * MiB;
constexpr size_t WS_M1 = 452 * MiB;
constexpr size_t WS_END_REQ = 512 * MiB;
constexpr size_t WS_M1b = 244 * MiB;
constexpr size_t WS_AL = 312 * MiB;
constexpr size_t WS_SB = 312 * MiB;
constexpr size_t WS_F = 380 * MiB;
constexpr size_t WS_ACT = 108 * MiB;

constexpr int RING_BYTES = 131072, MISC_OFF = RING_BYTES + 320, LDS_BYTES = 147456;

#define GAS __attribute__((address_space(1)))
#define LAS __attribute__((address_space(3)))
typedef unsigned short bf16;
typedef unsigned v4u __attribute__((ext_vector_type(4)));
typedef unsigned v2u __attribute__((ext_vector_type(2)));
typedef float f32x4 __attribute__((ext_vector_type(4)));
#define LDS_WAIT() asm volatile("s_waitcnt lgkmcnt(0)" ::: "memory")
#define VM_WAIT() asm volatile("s_waitcnt vmcnt(0)" ::: "memory")
__device__ __forceinline__ unsigned pk2(float lo, float hi) { return att::cvtpk(lo, hi); }
__device__ __forceinline__ float bf2f(unsigned short b) { return __uint_as_float((unsigned)b << 16); }
__device__ __forceinline__ v2u pk4(f32x4 v) { v2u w; w.x = pk2(v[0], v[1]); w.y = pk2(v[2], v[3]); return w; }
__device__ __forceinline__ f32x4 unpk4(v2u w) { f32x4 v; v[0] = __uint_as_float(w.x << 16); v[1] = __uint_as_float(w.x & 0xffff0000u); v[2] = __uint_as_float(w.y << 16); v[3] = __uint_as_float(w.y & 0xffff0000u); return v; }

#define XB_TMO      128
#define XB_XCNT(j)  (256  + 64 * (j))
#define XB_XSUB(j)  (1280 + 64 * (j))
#define XB_XGEN(j)  (2304 + 64 * (j))
#define XB_TOP      3328
#define XB_TOPGEN   3392
#define XCD_BAR_WORDS 3456
#define XB_SPIN_CAP (1u << 22)
__device__ __forceinline__ unsigned xb_ld(unsigned* p)              { return __hip_atomic_load(p, __ATOMIC_RELAXED, __HIP_MEMORY_SCOPE_AGENT); }
__device__ __forceinline__ unsigned xb_add(unsigned* p, unsigned v) { return __hip_atomic_fetch_add(p, v, __ATOMIC_RELAXED, __HIP_MEMORY_SCOPE_AGENT); }
__device__ __forceinline__ unsigned xb_xcc_id() { return (unsigned)__builtin_amdgcn_s_getreg((3 << 11) | 20) & 0xFu; }
#define XB_SPIN(cond, bar) do { unsigned _sp = 0; while (cond) { __builtin_amdgcn_s_sleep(1); \
    if ((++_sp & 255u) == 0u) { if (xb_ld(&(bar)[XB_TMO])) break; if (_sp > XB_SPIN_CAP) { atomicAdd(&(bar)[XB_TMO], 1u); break; } } } } while (0)
struct XcdBarrier { unsigned* bar; unsigned x; volatile LAS unsigned* st; };
__device__ __forceinline__ XcdBarrier xcd_barrier_post(unsigned* bar, volatile LAS unsigned* st) {
    XcdBarrier b; b.bar = bar; b.x = xb_xcc_id(); b.st = st;
    if (threadIdx.x == 0) (void)xb_add(&bar[XB_XCNT(b.x)], 1u);
    return b;
}
__device__ __forceinline__ void xcd_barrier_complete(unsigned* bar, unsigned x, unsigned& nloc, unsigned& nx) {
    const unsigned G = gridDim.x * gridDim.y * gridDim.z;
    unsigned sum, cnt, mine, sp = 0u;
    for (;;) {
        sum = 0u; cnt = 0u; mine = 0u;
#pragma unroll
        for (unsigned j = 0; j < 16; ++j) { const unsigned c = xb_ld(&bar[XB_XCNT(j)]); sum += c; cnt += (c > 0u) ? 1u : 0u; mine = (j == x) ? c : mine; }
        if (sum == G) break;
        __builtin_amdgcn_s_sleep(1);
        if ((++sp & 255u) == 0u) { if (xb_ld(&bar[XB_TMO])) break; if (sp > XB_SPIN_CAP) { atomicAdd(&bar[XB_TMO], 1u); break; } }
    }
    nloc = mine > 0u ? mine : 1u; nx = cnt > 0u ? cnt : 1u;
}
__device__ __forceinline__ void xcd_barrier(const XcdBarrier& b) {
    asm volatile("s_waitcnt vmcnt(0)" ::: "memory");
    __syncthreads();
    if (threadIdx.x == 0) {
        unsigned* bar = b.bar;
        __builtin_amdgcn_s_waitcnt(0);
        unsigned nloc = b.st[0], nx = b.st[1];
        if (nloc == 0u) { xcd_barrier_complete(bar, b.x, nloc, nx); b.st[0] = nloc; b.st[1] = nx; }
        const unsigned old = xb_add(&bar[XB_XSUB(b.x)], 1u);
        const unsigned gen = old / nloc;
        if (old + 1u == (gen + 1u) * nloc) {
            __builtin_amdgcn_fence(__ATOMIC_RELEASE, "agent");
            asm volatile("s_waitcnt vmcnt(0)" ::: "memory");
            const unsigned og = xb_add(&bar[XB_TOP], 1u);
            const unsigned tg = og / nx;
            if (og + 1u == (tg + 1u) * nx) xb_add(&bar[XB_TOPGEN], 1u);
            else XB_SPIN(xb_ld(&bar[XB_TOPGEN]) == tg, bar);
            __builtin_amdgcn_fence(__ATOMIC_ACQUIRE, "agent");
            xb_add(&bar[XB_XGEN(b.x)], 1u);
            asm volatile("s_waitcnt vmcnt(0)" ::: "memory");
        } else {
            XB_SPIN(xb_ld(&bar[XB_XGEN(b.x)]) == gen, bar);
            __builtin_amdgcn_fence(__ATOMIC_ACQUIRE, "agent");
            asm volatile("s_waitcnt vmcnt(0)" ::: "memory");
        }
    }
    __syncthreads();
}

#if 1
#define NTL(p) __builtin_nontemporal_load(p)
#define NTS(v, p) __builtin_nontemporal_store(v, p)
#else
#define NTL(p) (*(p))
#define NTS(v, p) (*(p) = (v))
#endif
__device__ __forceinline__ float ssq4(f32x4 v) { return (v[0] * v[0] + v[1] * v[1]) + (v[2] * v[2] + v[3] * v[3]); }
__device__ __forceinline__ float wave_sum(float v) {
#pragma unroll
    for (int o = 1; o < 64; o <<= 1) v += __shfl_xor(v, o);
    return v;
}
__device__ __forceinline__ float silu_f(float v) { return v * __builtin_amdgcn_rcpf(1.f + __builtin_amdgcn_exp2f(-1.4426950408889634f * v)); }
__device__ __forceinline__ float sigmoid_f(float v) { return __builtin_amdgcn_rcpf(1.f + __builtin_amdgcn_exp2f(-1.4426950408889634f * v)); }

struct Args { const float* in[24]; float* out; unsigned char* ws; };
enum { I_X = 0, I_C, I_CTX, I_CCTX, I_WADA, I_BADA, I_APRE, I_APOST, I_WIN, I_BGATE, I_QNG, I_WQUP, I_KVNG, I_WKVUP, I_WOM, I_SINK, I_WOS, I_WOUT, I_FPRE, I_FPOST, I_WUP, I_CONVW, I_CONVB, I_WDN };
__device__ __forceinline__ void transpose_item(const float* W, int N, int k0, int n0, bf16* WT, int ldw, int drow0, int dk0, const float* gain, LAS float* scr, int lane, int perm) {
#pragma unroll 8
    for (int i = 0; i < 32; ++i) { const int kk = 2 * i + (lane >> 5); float v = W[(size_t)(k0 + kk) * N + n0 + (lane & 31)]; if (gain) v *= gain[k0 + kk]; scr[kk * 33 + (lane & 31)] = v; }
    LDS_WAIT(); asm volatile("" ::: "memory");
    const int c = lane & 7;
#pragma unroll
    for (int j = 0; j < 4; ++j) { const int n = (lane >> 3) + 8 * j; const LAS float* s = scr + (8 * c) * 33 + n;
        v4u o; o.x = pk2(s[0 * 33], s[1 * 33]); o.y = pk2(s[2 * 33], s[3 * 33]); o.z = pk2(s[4 * 33], s[5 * 33]); o.w = pk2(s[6 * 33], s[7 * 33]);
        int dr;
        if (perm == 2) { const int tb = 1280 + (((drow0 - 1280) >> 8) << 8), L = ((drow0 - 1280) & 255) + n;
                         dr = tb + 128 * ((L >> 3) & 1) + 32 * (L >> 6) + 16 * ((L >> 2) & 1) + 4 * ((L >> 4) & 3) + (L & 3); }
        else dr = drow0 + (perm ? 16 * ((n >> 2) & 1) + 4 * (n >> 3) + (n & 3) : n);
        *(GAS v4u*)(WT + (size_t)dr * ldw + dk0 + k0 + 8 * c) = o; }
    LDS_WAIT(); asm volatile("" ::: "memory");
}
__device__ __forceinline__ int inproj_row(int n) {
    if (n < 416) return n;
    if (n < 928) return n - 416 + 768;
    if (n < 1056) return n - 928 + 512;
    if (n < 1184) return n - 1056 + 640;
    return n - 1184 + 1280;
}
__device__ __forceinline__ float inv_freq16(int f) {
    switch (f) { case 0: return 1.0f; case 1: return 0.5623413324356079f; case 2: return 0.3162277638912201f; case 3: return 0.17782793939113617f; case 4: return 0.10000000149011612f;
        case 5: return 0.05623413249850273f; case 6: return 0.03162277489900589f; case 7: return 0.017782794311642647f; case 8: return 0.009999999776482582f; case 9: return 0.005623413249850273f;
        case 10: return 0.003162277629598975f; case 11: return 0.0017782794311642647f; case 12: return 0.0010000000474974513f; case 13: return 0.000562341301701963f;
        case 14: return 0.0003162277571391314f; default: return 0.00017782794020604342f; }
}
__device__ __forceinline__ void sincos_acc(float ang, float& c, float& s) {
    const double a = (double)ang;
    const double k = __builtin_rint(a * 0.63661977236758134308);
    const double r = (a - k * 1.5707963267948966192) - k * 6.123233995736766e-17;
    const double r2 = r * r;
    const double sn = r * (1.0 + r2 * (-1.0 / 6 + r2 * (1.0 / 120 + r2 * (-1.0 / 5040 + r2 * (1.0 / 362880 + r2 * (-1.0 / 39916800 + r2 * (1.0 / 6227020800.0)))))));
    const double cs = 1.0 + r2 * (-0.5 + r2 * (1.0 / 24 + r2 * (-1.0 / 720 + r2 * (1.0 / 40320 + r2 * (-1.0 / 3628800 + r2 * (1.0 / 479001600.0 + r2 * (-1.0 / 87178291200.0)))))));
    const int q = ((int)k) & 3;
    const double cc = (q == 0) ? cs : (q == 1) ? -sn : (q == 2) ? -cs : sn;
    const double ss = (q == 0) ? sn : (q == 1) ? cs : (q == 2) ? -sn : -cs;
    c = (float)cc; s = (float)ss;
}
__device__ __forceinline__ void p0_prologue(const Args& a, LAS unsigned char* lds, int vcu, int G, int tid, int lane, int wave) {
    unsigned char* ws = a.ws;
    LAS float* scr = (LAS float*)(lds + wave * 16384);
    const int gw = vcu * NWAVES + wave, NGW = G * NWAVES;
    bf16* WIN = (bf16*)(ws + WS_WIN); bf16* WQ = (bf16*)(ws + WS_WQ); bf16* WKV = (bf16*)(ws + WS_WKV); bf16* WOAB = (bf16*)(ws + WS_WOAB);
    bf16* WOUT = (bf16*)(ws + WS_WOUT); bf16* WUP = (bf16*)(ws + WS_WUP); bf16* WDN = (bf16*)(ws + WS_WDN);
    constexpr int I_IN = 16 * (DIN / 32), I_Q = 4 * 24, I_KV = 2 * 32, I_OA = 8 * 32, I_OB = 8 * 32, I_OUT = 16 * 32, I_UP = 16 * (DUP / 32), I_DN = 44 * 32;
    constexpr int NITEMS = I_IN + I_Q + I_KV + I_OA + I_OB + I_OUT + I_UP + I_DN;
    for (int it = gw; it < NITEMS; it += NGW) {
        int r = it;
        if (r < I_IN) { const int nblk = DIN / 32, kb = r / nblk, nb = r % nblk; { const int dr = inproj_row(32 * nb); const int pm_ = (dr >= 1280) ? 2 : ((dr < 384) || (dr >= 640 && dr < 768)) ? 1 : 0;
              transpose_item(a.in[I_WIN], DIN, 64 * kb, 32 * nb, WIN, 1024, dr, 0, nullptr, scr, lane, pm_); } continue; } r -= I_IN;
        if (r < I_Q) { const int kb = r / 24, nb = r % 24, n0 = 32 * nb, hd = n0 / 96, cc = n0 % 96; const int drow = cc < 64 ? hd * 64 + cc : 512 + hd * 32 + (cc - 64);
            transpose_item(a.in[I_WQUP], 768, 64 * kb, n0, WQ, 256, drow, 0, a.in[I_QNG], scr, lane, cc < 64); continue; } r -= I_Q;
        if (r < I_KV) { const int kb = r / 32, nb = r % 32, n0 = 32 * nb, hd = n0 / 128, cc = n0 % 128; const int drow = cc < 64 ? hd * 64 + cc : 512 + hd * 64 + (cc - 64);
            transpose_item(a.in[I_WKVUP], 1024, 64 * kb, n0, WKV, 256, drow, 0, a.in[I_KVNG], scr, lane, true); continue; } r -= I_KV;
        if (r < I_OA) { const int kb = r / 32, nb = r % 32; transpose_item(a.in[I_WOM], 1024, 64 * kb, 32 * nb, WOAB, 1024, 32 * nb, 0, nullptr, scr, lane, true); continue; } r -= I_OA;
        if (r < I_OB) { const int kb = r / 32, nb = r % 32; transpose_item(a.in[I_WOS], 1024, 64 * kb, 32 * nb, WOAB, 1024, 32 * nb, 512, nullptr, scr, lane, true); continue; } r -= I_OB;
        if (r < I_OUT) { const int kb = r / 32, nb = r % 32; transpose_item(a.in[I_WOUT], 1024, 64 * kb, 32 * nb, WOUT, 1024, 32 * nb, 0, nullptr, scr, lane, true); continue; } r -= I_OUT;
        if (r < I_UP) { const int nblk = DUP / 32, kb = r / nblk, nb = r % nblk, n0 = 32 * nb; const int drow = n0 < DFF ? (n0 / 128) * 256 + (n0 % 128) : ((n0 - DFF) / 128) * 256 + 128 + ((n0 - DFF) % 128);
            transpose_item(a.in[I_WUP], DUP, 64 * kb, n0, WUP, 1024, drow, 0, nullptr, scr, lane, true); continue; } r -= I_UP;
        { const int kb = r / 32, nb = r % 32; transpose_item(a.in[I_WDN], 1024, 64 * kb, 32 * nb, WDN, DFF, 32 * nb, 0, nullptr, scr, lane, true); }
    }
    { const int gt = vcu * 512 + tid, NTH = G * 512;
      for (int i = gt; i < 96 * 128; i += NTH) *(GAS v4u*)(WIN + (size_t)(416 + i / 128) * 1024 + (i % 128) * 8) = (v4u){0u, 0u, 0u, 0u};
      for (int i = gt; i < 1024 * 16; i += NTH) *(GAS v4u*)(WKV + (size_t)(i / 16) * 256 + 128 + (i % 16) * 8) = (v4u){0u, 0u, 0u, 0u};
      float2* RS = (float2*)(ws + WS_ROPE_S); float2* RM = (float2*)(ws + WS_ROPE_M);
      for (int i = gt; i < 64 * 16 + 64 * 8; i += NTH) {
          const bool sw = i < 64 * 16; const int j = sw ? i : i - 64 * 16; const int pos = sw ? j / 16 : j / 8, f = sw ? j % 16 : j % 8;
          const int f16 = sw ? f : 2 * f;
          const float inv = inv_freq16(f16);
          const float ang = (float)pos * inv; float c, s; sincos_acc(ang, c, s);
          if (sw) RS[j] = make_float2(c, s); else RM[j] = make_float2(c, s);
      }
    }
    { LAS float* sv = (LAS float*)(lds + wave * 16384 + 12288);
      float* MODP = (float*)(ws + WS_MODP); const float* wada = a.in[I_WADA];
      for (int task = gw; task < 96 * 16; task += NGW) {
          const int cg = task % 96, ks = task / 96, col = cg * 64 + lane, kk0 = ks * 64;
#pragma unroll
          for (int b = 0; b < 9; ++b) { const float cv = (b < 8) ? a.in[I_C][b * 1024 + kk0 + lane] : a.in[I_CCTX][kk0 + lane]; sv[b * 64 + lane] = silu_f(cv); }
          LDS_WAIT(); asm volatile("" ::: "memory");
          float acc[9];
#pragma unroll
          for (int b = 0; b < 9; ++b) acc[b] = 0.f;
#pragma unroll 8
          for (int k = 0; k < 64; ++k) { const float w = wada[(size_t)(kk0 + k) * 6144 + col];
#pragma unroll
              for (int b = 0; b < 9; ++b) acc[b] = fmaf(sv[b * 64 + k], w, acc[b]); }
#pragma unroll
          for (int b = 0; b < 9; ++b) MODP[(size_t)(ks * 9 + b) * 6144 + col] = acc[b];
          LDS_WAIT(); asm volatile("" ::: "memory");
      }
    }
}
__device__ __forceinline__ float mod_from_partials(const float* MODP, const float* bada, int b, int j) {
    float s = bada[j];
#pragma unroll
    for (int ks = 0; ks < 16; ++ks) s += MODP[(size_t)(ks * 9 + b) * 6144 + j];
    return s;
}

__device__ __forceinline__ void p1_norm_mod(const Args& a, LAS unsigned char* lds, int vcu, int G, int tid, int lane, int wave) {
    unsigned char* ws = a.ws; const float* MODP = (const float*)(ws + WS_MODP); float* MODF = (float*)(ws + WS_MODF);
    for (int i = vcu * 512 + tid; i < 9 * 6144; i += G * 512) MODF[i] = mod_from_partials(MODP, a.in[I_BADA], i / 6144, i % 6144);
    LAS float* msh = (LAS float*)lds;
    LAS float* msc = msh + 1024;
    LAS float* mg = msc + 1024;
    bf16* H = (bf16*)(ws + WS_H);
    const int rows_per = (RT + G - 1) / G;
    int r = vcu * rows_per; const int rend = (r + rows_per < RT) ? r + rows_per : RT;
    while (r < rend) {
        const int b = r / TPB, t = r % TPB; const bool ctx = t < CTX; const int seg_end = b * TPB + (ctx ? CTX : TPB); const int e = seg_end < rend ? seg_end : rend;
        const int mb = ctx ? 8 : b;
        __syncthreads();
        for (int j = tid; j < 1024; j += 512) { msh[j] = mod_from_partials(MODP, a.in[I_BADA], mb, j); msc[j] = 1.f + mod_from_partials(MODP, a.in[I_BADA], mb, 1024 + j); mg[j] = a.in[I_APRE][j]; }
        __syncthreads();
        for (int row0 = r + 2 * wave; row0 < e; row0 += 2 * NWAVES) {
            const bool two = row0 + 1 < e; const int row1 = two ? row0 + 1 : row0;
            const int t0 = row0 - b * TPB, t1 = row1 - b * TPB;
            const float* src0 = ctx ? a.in[I_CTX] + (size_t)(b * CTX + t0) * 1024 : a.in[I_X] + (size_t)(b * SEQ + t0 - CTX) * 1024;
            const float* src1 = ctx ? a.in[I_CTX] + (size_t)(b * CTX + t1) * 1024 : a.in[I_X] + (size_t)(b * SEQ + t1 - CTX) * 1024;
            const GAS f32x4* xr0 = (const GAS f32x4*)src0 + lane; const GAS f32x4* xr1 = (const GAS f32x4*)src1 + lane;
            f32x4 v0[4], v1[4]; float s0 = 0.f, s1 = 0.f;
#pragma unroll
            for (int j = 0; j < 4; ++j) { v0[j] = NTL(xr0 + 64 * j); v1[j] = NTL(xr1 + 64 * j); }
#pragma unroll
            for (int j = 0; j < 4; ++j) { s0 += ssq4(v0[j]); s1 += ssq4(v1[j]); }
            const float rstd0 = 1.f / sqrtf(wave_sum(s0) * (1.f / 1024.f) + EPS), rstd1 = 1.f / sqrtf(wave_sum(s1) * (1.f / 1024.f) + EPS);
            GAS v2u* o80 = (GAS v2u*)(H + (size_t)row0 * 1024) + lane; GAS v2u* o81 = (GAS v2u*)(H + (size_t)row1 * 1024) + lane;
#pragma unroll
            for (int j = 0; j < 4; ++j) { const int c0 = 4 * lane + 256 * j; f32x4 oa, ob;
#pragma unroll
                for (int i = 0; i < 4; ++i) { const float gg = mg[c0 + i] * msc[c0 + i], sh = msh[c0 + i]; oa[i] = (v0[j][i] * rstd0) * gg + sh; ob[i] = (v1[j][i] * rstd1) * gg + sh; }
                NTS(pk4(oa), o80 + 64 * j); if (two) NTS(pk4(ob), o81 + 64 * j); }
        }
        r = e;
    }
    __syncthreads();
}
typedef pg8::f32x4 (AccT)[2][2][4][2];
using pg8::Unit;
#ifdef NT_STORES
__device__ __forceinline__ void st4(bf16* p, f32x4 v) { __builtin_nontemporal_store(pk4(v), (GAS v2u*)p); }
#else
__device__ __forceinline__ void st4(bf16* p, f32x4 v) { *(GAS v2u*)p = pk4(v); }
#endif
__device__ __forceinline__ void st8(bf16* p, f32x4 a, f32x4 b) { v4u w; w.x = pk2(a[0], a[1]); w.y = pk2(a[2], a[3]); w.z = pk2(b[0], b[1]); w.w = pk2(b[2], b[3]);
#ifdef NT_STORES
    __builtin_nontemporal_store(w, (GAS v4u*)p);
#else
    *(GAS v4u*)p = w;
#endif
}
__device__ __forceinline__ v4u pack8(f32x4 a, f32x4 b) { v4u w; w.x = pk2(a[0], a[1]); w.y = pk2(a[2], a[3]); w.z = pk2(b[0], b[1]); w.w = pk2(b[2], b[3]); return w; }
__device__ __forceinline__ v4u tr_lanes(v4u w, int src4) { v4u r; r.x = __builtin_amdgcn_ds_bpermute(src4, w.x); r.y = __builtin_amdgcn_ds_bpermute(src4, w.y); r.z = __builtin_amdgcn_ds_bpermute(src4, w.z); r.w = __builtin_amdgcn_ds_bpermute(src4, w.w); return r; }
__device__ __forceinline__ void ld8(const bf16* p, f32x4& a, f32x4& b) { const v4u w = *(const GAS v4u*)p; a = unpk4((v2u){w.x, w.y}); b = unpk4((v2u){w.z, w.w}); }
__device__ __forceinline__ f32x4 shx32(f32x4 v) { f32x4 r; r[0] = __shfl_xor(v[0], 32); r[1] = __shfl_xor(v[1], 32); r[2] = __shfl_xor(v[2], 32); r[3] = __shfl_xor(v[3], 32); return r; }
__device__ __forceinline__ void rope_pair(f32x4& x0, f32x4& x1, const float2* cs) {
#pragma unroll
    for (int i = 0; i < 4; ++i) { const float c = cs[i].x, s = cs[i].y, a = x0[i], b = x1[i]; x0[i] = a * c - b * s; x1[i] = b * c + a * s; }
}

__device__ __forceinline__ unsigned gate_q4(f32x4 g) { unsigned r = 0;
#pragma unroll
    for (int i = 0; i < 4; ++i) r |= (unsigned)__builtin_rintf(g[i] * 255.f) << (8 * i);
    return r; }
__device__ __forceinline__ f32x4 gate_dq4(unsigned w) { f32x4 g;
#pragma unroll
    for (int i = 0; i < 4; ++i) g[i] = (float)((w >> (8 * i)) & 255u) * (1.f / 255.f);
    return g; }
__device__ __forceinline__ void ldg8(const unsigned char* p, f32x4& a, f32x4& b) { const v2u w = *(const GAS v2u*)p; a = gate_dq4(w.x); b = gate_dq4(w.y); }
constexpr float QSCALE_MLA = 0.10206207261596575f * 1.4426950408889634f, QSCALE_SWA = 0.125f * 1.4426950408889634f;
struct LaneTr { int fr, fq, frs, fqs, src4; __device__ __forceinline__ LaneTr(int fr_, int fq_) { fr = fr_; fq = fq_; const int lane = fq * 16 + fr; frs = lane >> 2; fqs = lane & 3; src4 = (fqs * 16 + frs) * 4; } };
#ifndef TR_IN
#define TR_IN false
#define TR_GATE false
#define TR_UP3 false
#define TR_MERGE false
#define TR_FUP false
#endif
template <bool TR = true> __device__ __forceinline__ void st8c(bf16* base, size_t ld, int rb, int cb, const LaneTr& L, f32x4 a, f32x4 b) {
    if (TR) *(GAS v4u*)(base + (size_t)(rb + L.frs) * ld + cb + 8 * L.fqs) = tr_lanes(pack8(a, b), L.src4);
    else    *(GAS v4u*)(base + (size_t)(rb + L.fr) * ld + cb + 8 * L.fq) = pack8(a, b); }
struct EpiInProj {
    static constexpr int MID_T = 0;
    bf16 *QA, *KVR, *KR, *KS, *VS, *QS; unsigned char* GT; float *SSQ_Q, *SSQ_KV; const float* b_gate; const float2* RS; const float2* RM;
    __device__ __forceinline__ void operator()(const AccT& acc, const Unit& u, int wr, int wc, int fr, int fq) const {
        const int tin = u.pm % 17; const bool ctx = (tin == 0);
        const int row0 = u.pm * 256 + wr * 64 + fr;
        const int pos0 = (tin - 1) * 256 + wr * 64 + fr;
        const int cw = wc * 32 + fq * 4;
        const int c8 = wc * 32 + fq * 8;
        const LaneTr LT(fr, fq); const int rb0 = u.pm * 256 + wr * 64, cwv = wc * 32; (void)c8;
        if (u.pn == 0) {
#pragma unroll
            for (int ai = 0; ai < 2; ++ai)
#pragma unroll
                for (int m = 0; m < 4; ++m) { const int row = row0 + ai * 128 + m * 16; float s = 0.f;
#pragma unroll
                    for (int bj = 0; bj < 2; ++bj) { s += ssq4(acc[ai][bj][m][0]) + ssq4(acc[ai][bj][m][1]); st8c<TR_IN>(QA, 256, rb0 + ai * 128 + m * 16, bj * 128 + cwv, LT, acc[ai][bj][m][0], acc[ai][bj][m][1]); }
                    s += __shfl_xor(s, 16); s += __shfl_xor(s, 32); if (fq == 0) SSQ_Q[(size_t)row * 4 + wc] = s; }
        } else if (u.pn == 1) {
#pragma unroll
            for (int ai = 0; ai < 2; ++ai)
#pragma unroll
                for (int m = 0; m < 4; ++m) { const int row = row0 + ai * 128 + m * 16; float s = 0.f;
                    s += ssq4(acc[ai][0][m][0]) + ssq4(acc[ai][0][m][1]); st8c<TR_IN>(KVR, 256, rb0 + ai * 128 + m * 16, cwv, LT, acc[ai][0][m][0], acc[ai][0][m][1]);
#pragma unroll
                    for (int n = 0; n < 2; ++n) st4(KVR + (size_t)row * 256 + 128 + cw + n * 16, acc[ai][1][m][n]);
                    s += __shfl_xor(s, 16); s += __shfl_xor(s, 32); if (fq == 0) SSQ_KV[(size_t)row * 4 + wc] = s;
                    if (wc == 0) {
                        const int pos = pos0 + ai * 128 + m * 16;
#pragma unroll
                        for (int n = 0; n < 2; ++n) { f32x4 v = acc[ai][1][m][n]; const f32x4 p = shx32(v);
                            if (!ctx) { const int pi = (n == 0) ? (pos >> 6) : (pos & 63); const float2* cs = RM + pi * 8 + (fq & 1) * 4;
#pragma unroll
                                for (int i = 0; i < 4; ++i) v[i] = (fq < 2) ? v[i] * cs[i].x - p[i] * cs[i].y : v[i] * cs[i].x + p[i] * cs[i].y; }
                            st4(KR + (size_t)row * 32 + n * 16 + fq * 4, v); }
                    } }
        } else if (u.pn == 2) {
#pragma unroll
            for (int ai = 0; ai < 2; ++ai)
#pragma unroll
                for (int m = 0; m < 4; ++m) { const int row = row0 + ai * 128 + m * 16; const int pos = pos0 + ai * 128 + m * 16;
                    f32x4 x0 = acc[ai][0][m][0], x1 = acc[ai][0][m][1];
                    if (!ctx) { const int pi = (wc & 1) ? (pos & 63) : (pos >> 6); rope_pair(x0, x1, RS + pi * 16 + fq * 4); }
                    st4(KS + (size_t)row * 128 + cw, x0); st4(KS + (size_t)row * 128 + cw + 16, x1);
                    st8c<TR_IN>(VS, 128, rb0 + ai * 128 + m * 16, cwv, LT, acc[ai][1][m][0], acc[ai][1][m][1]); }
        } else if (u.pn <= 4) {
            const int cb = (u.pn - 3) * 256;
#pragma unroll
            for (int ai = 0; ai < 2; ++ai)
#pragma unroll
                for (int m = 0; m < 4; ++m) { const int row = row0 + ai * 128 + m * 16; const int pos = pos0 + ai * 128 + m * 16;
                    const int pi = (wc & 1) ? (pos & 63) : (pos >> 6); const float2* cs = RS + pi * 16 + fq * 4;
#pragma unroll
                    for (int bj = 0; bj < 2; ++bj) { f32x4 x0 = acc[ai][bj][m][0] * QSCALE_SWA, x1 = acc[ai][bj][m][1] * QSCALE_SWA; rope_pair(x0, x1, cs);
                        st4(QS + (size_t)row * 512 + cb + bj * 128 + cw, x0); st4(QS + (size_t)row * 512 + cb + bj * 128 + cw + 16, x1); } }
        } else {
            const int cb = (u.pn - 5) * 256, c16 = wc * 64 + fq * 16;
            f32x4 bv[2][2];
#pragma unroll
            for (int bj = 0; bj < 2; ++bj)
#pragma unroll
                for (int n = 0; n < 2; ++n) bv[bj][n] = *(const f32x4*)(b_gate + cb + c16 + bj * 8 + n * 4);
#pragma unroll
            for (int ai = 0; ai < 2; ++ai)
#pragma unroll
                for (int m = 0; m < 4; ++m) { const int row = row0 + ai * 128 + m * 16; v4u w;
#pragma unroll
                    for (int bj = 0; bj < 2; ++bj) { f32x4 v0 = acc[ai][bj][m][0] + bv[bj][0], v1 = acc[ai][bj][m][1] + bv[bj][1];
#pragma unroll
                        for (int i = 0; i < 4; ++i) { v0[i] = sigmoid_f(v0[i]); v1[i] = sigmoid_f(v1[i]); }
                        if (bj == 0) { w.x = gate_q4(v0); w.y = gate_q4(v1); } else { w.z = gate_q4(v0); w.w = gate_q4(v1); } }
                    if (TR_GATE) *(GAS v4u*)(GT + (size_t)(rb0 + ai * 128 + m * 16 + LT.frs) * 2048 + cb + wc * 64 + LT.fqs * 16) = tr_lanes(w, LT.src4);
                    else *(GAS v4u*)(GT + (size_t)row * 2048 + cb + c16) = w; }
        }
    }
};
struct EpiQUp {
    static constexpr int MID_T = 0;
    bf16 *QN, *QR; const float* SSQ_Q; const float2* RM;
    __device__ __forceinline__ void operator()(const AccT& acc, const Unit& u, int wr, int wc, int fr, int fq) const {
        const int tin = u.pm % 17; const int row0 = u.pm * 256 + wr * 64 + fr, pos0 = (tin - 1) * 256 + wr * 64 + fr, cw = wc * 32 + fq * 4; const LaneTr LT(fr, fq);
#pragma unroll
        for (int ai = 0; ai < 2; ++ai)
#pragma unroll
            for (int m = 0; m < 4; ++m) { const int row = row0 + ai * 128 + m * 16; const int pos = pos0 + ai * 128 + m * 16;
                asm volatile("" ::: "memory"); __builtin_amdgcn_sched_barrier(0);
                const f32x4 sq = *(const f32x4*)(SSQ_Q + (size_t)row * 4); const float rs = QSCALE_MLA / sqrtf(((sq[0] + sq[1]) + (sq[2] + sq[3])) * (1.f / 256.f) + EPS);
                if (u.pn < 2) {
#pragma unroll
                    for (int bj = 0; bj < 2; ++bj) st8c<TR_UP3>(QN, 512, u.pm * 256 + wr * 64 + ai * 128 + m * 16, u.pn * 256 + bj * 128 + wc * 32, LT, acc[ai][bj][m][0] * rs, acc[ai][bj][m][1] * rs);
                } else {
#pragma unroll
                    for (int bj = 0; bj < 2; ++bj)
#pragma unroll
                        for (int n = 0; n < 2; ++n) { f32x4 v = acc[ai][bj][m][n] * rs; const f32x4 p = shx32(v);
                            const int pi = (n == 0) ? (pos >> 6) : (pos & 63); const float2* cs = RM + pi * 8 + (fq & 1) * 4;
#pragma unroll
                            for (int i = 0; i < 4; ++i) v[i] = (fq < 2) ? v[i] * cs[i].x - p[i] * cs[i].y : v[i] * cs[i].x + p[i] * cs[i].y;
                            st4(QR + (size_t)row * 256 + (bj * 4 + wc) * 32 + n * 16 + fq * 4, v); }
                } }
    }
};
struct EpiKVUp {
    static constexpr int MID_T = 0;
    bf16 *KN, *VM; const float* SSQ_KV;
    __device__ __forceinline__ void operator()(const AccT& acc, const Unit& u, int wr, int wc, int fr, int fq) const {
        const int row0 = u.pm * 256 + wr * 64 + fr; const LaneTr LT(fr, fq);
        bf16* dst = (u.pn < 2) ? KN + u.pn * 256 : VM + (u.pn - 2) * 256;
#pragma unroll
        for (int ai = 0; ai < 2; ++ai)
#pragma unroll
            for (int m = 0; m < 4; ++m) { const int row = row0 + ai * 128 + m * 16;
                asm volatile("" ::: "memory"); __builtin_amdgcn_sched_barrier(0);
                const f32x4 sq = *(const f32x4*)(SSQ_KV + (size_t)row * 4); const float rs = 1.f / sqrtf(((sq[0] + sq[1]) + (sq[2] + sq[3])) * (1.f / 128.f) + EPS);
#pragma unroll
                for (int bj = 0; bj < 2; ++bj) st8c<TR_UP3>(dst, 512, u.pm * 256 + wr * 64 + ai * 128 + m * 16, bj * 128 + wc * 32, LT, acc[ai][bj][m][0] * rs, acc[ai][bj][m][1] * rs); }
    }
};
struct EpiUp3 {
    static constexpr int MID_T = 0; EpiQUp q; EpiKVUp kv;
    __device__ __forceinline__ void operator()(const AccT& acc, const Unit& u, int wr, int wc, int fr, int fq) const {
        if (u.pm >= 136) { Unit v; v.pm = u.pm - 136; v.pn = u.pn - 3; kv(acc, v, wr, wc, fr, fq); } else q(acc, u, wr, wc, fr, fq);
    }
};
struct EpiMerge {
    static constexpr int MID_T = 8;
    bf16* M1; const unsigned char* GT;
    __device__ __forceinline__ void mid(AccT& acc, const Unit& u, int wr, int wc, int fr, int fq) const {
        const int row0 = u.pm * 256 + wr * 64 + fr, c0 = u.pn * 256 + wc * 32 + fq * 8;
#pragma unroll
        for (int ai = 0; ai < 2; ++ai)
#pragma unroll
            for (int m = 0; m < 4; ++m) { const int row = row0 + ai * 128 + m * 16;
#pragma unroll
                for (int bj = 0; bj < 2; ++bj) { const int col = c0 + bj * 128;
                    f32x4 ga0, ga1, gb0, gb1; ldg8(GT + (size_t)row * 2048 + col, ga0, ga1); ldg8(GT + (size_t)row * 2048 + 1024 + col, gb0, gb1);
#pragma unroll
                    for (int i = 0; i < 4; ++i) { acc[ai][bj][m][0][i] *= ga0[i] * __builtin_amdgcn_rcpf(fmaxf(gb0[i], 1e-18f)); acc[ai][bj][m][1][i] *= ga1[i] * __builtin_amdgcn_rcpf(fmaxf(gb1[i], 1e-18f)); } } }
    }
    __device__ __forceinline__ void operator()(const AccT& acc, const Unit& u, int wr, int wc, int fr, int fq) const {
        const int row0 = u.pm * 256 + wr * 64 + fr, c0 = u.pn * 256 + wc * 32 + fq * 8; const LaneTr LT(fr, fq);
#pragma unroll
        for (int ai = 0; ai < 2; ++ai)
#pragma unroll
            for (int m = 0; m < 4; ++m) { const int row = row0 + ai * 128 + m * 16;
#pragma unroll
                for (int bj = 0; bj < 2; ++bj) { const int col = c0 + bj * 128;
                    f32x4 gb0, gb1, o0, o1; ldg8(GT + (size_t)row * 2048 + 1024 + col, gb0, gb1);
#pragma unroll
                    for (int i = 0; i < 4; ++i) { o0[i] = fmaxf(gb0[i], 1e-18f) * acc[ai][bj][m][0][i]; o1[i] = fmaxf(gb1[i], 1e-18f) * acc[ai][bj][m][1][i]; }
                    st8c<TR_MERGE>(M1, 1024, u.pm * 256 + wr * 64 + ai * 128 + m * 16, u.pn * 256 + wc * 32 + bj * 128, LT, o0, o1); } }
    }
};
struct EpiOutSsq {
    static constexpr int MID_T = 0;
    bf16* O; float* SSQ;
    __device__ __forceinline__ void operator()(const AccT& acc, const Unit& u, int wr, int wc, int fr, int fq) const {
        const int lane = fq * 16 + fr, frs = lane >> 2, fqs = lane & 3, src4 = (fqs * 16 + frs) * 4;
        const int row0 = u.pm * 256 + wr * 64 + fr, rows0 = u.pm * 256 + wr * 64 + frs, cs0 = u.pn * 256 + wc * 32 + fqs * 8;
#pragma unroll
        for (int ai = 0; ai < 2; ++ai)
#pragma unroll
            for (int m = 0; m < 4; ++m) { const int row = row0 + ai * 128 + m * 16, rows = rows0 + ai * 128 + m * 16; float s = 0.f;
#pragma unroll
                for (int bj = 0; bj < 2; ++bj) { s += ssq4(acc[ai][bj][m][0]) + ssq4(acc[ai][bj][m][1]);
                    *(GAS v4u*)(O + (size_t)rows * 1024 + cs0 + bj * 128) = tr_lanes(pack8(acc[ai][bj][m][0], acc[ai][bj][m][1]), src4); }
                s += __shfl_xor(s, 16); s += __shfl_xor(s, 32); if (fq == 0) SSQ[(size_t)row * 16 + u.pn * 4 + wc] = s; }
    }
};
__device__ __forceinline__ f32x4 bperm4(int addr, f32x4 v) { f32x4 r;
#pragma unroll
    for (int i = 0; i < 4; ++i) r[i] = __int_as_float(__builtin_amdgcn_ds_bpermute(addr, __float_as_int(v[i])));
    return r; }
template <int CTRL> __device__ __forceinline__ f32x4 dpp4(f32x4 v) { f32x4 r;
#pragma unroll
    for (int i = 0; i < 4; ++i) r[i] = __int_as_float(__builtin_amdgcn_update_dpp(0, __float_as_int(v[i]), CTRL, 0xf, 0xf, false));
    return r; }
#ifndef DPP_PREV
#define DPP_PREV 0x121
#define DPP_NEXT 0x12F
#endif
__device__ __forceinline__ f32x4 sel4(bool c, f32x4 a, f32x4 b) { f32x4 r;
#pragma unroll
    for (int i = 0; i < 4; ++i) r[i] = c ? a[i] : b[i];
    return r; }
struct EpiNull {
    static constexpr int MID_T = 0; float* O;
    __device__ __forceinline__ void operator()(const AccT& acc, const Unit& u, int wr, int wc, int fr, int fq) const {
        f32x4 s = acc[0][0][0][0];
#pragma unroll
        for (int ai = 0; ai < 2; ++ai)
#pragma unroll
            for (int bj = 0; bj < 2; ++bj)
#pragma unroll
                for (int m = 0; m < 4; ++m)
#pragma unroll
                    for (int n = 0; n < 2; ++n) s = s + acc[ai][bj][m][n];
        if (s[0] + s[1] + s[2] + s[3] == 12345.678f) O[(u.pm * 4 + u.pn) * 512 + (wr * 4 + wc) * 64 + fq * 16 + fr] = s[0];
    }
};
struct EpiStoreOnly { static constexpr int MID_T = 0; bf16* O;
    __device__ __forceinline__ void operator()(const AccT& acc, const Unit& u, int wr, int wc, int fr, int fq) const {
        const int row0 = u.pm * 256 + wr * 64 + fr, c0 = u.pn * 256 + wc * 32 + fq * 8;
#pragma unroll
        for (int ai = 0; ai < 2; ++ai)
#pragma unroll
            for (int m = 0; m < 4; ++m) { const int row = row0 + ai * 128 + m * 16;
#pragma unroll
                for (int bj = 0; bj < 2; ++bj) st8(O + (size_t)row * 1024 + c0 + bj * 128, acc[ai][bj][m][0], acc[ai][bj][m][1]); }
    } };
template <int MODE> struct EpiStoreX { static constexpr int MID_T = 0; bf16* O;
    __device__ __forceinline__ void operator()(const AccT& acc, const Unit& u, int wr, int wc, int fr, int fq) const {
        const int row0 = (MODE == 2 ? (int)(blockIdx.x * 32) + ((wr * 64 + fr) & 31) : u.pm * 256 + wr * 64 + fr), c0 = (MODE == 2 ? 0 : u.pn * 256) + wc * 32 + fq * 8;
#pragma unroll
        for (int ai = 0; ai < 2; ++ai)
#pragma unroll
            for (int m = 0; m < 4; ++m) { const int row = (MODE == 2) ? row0 : row0 + ai * 128 + m * 16;
#pragma unroll
                for (int bj = 0; bj < (MODE == 1 ? 1 : 2); ++bj) st8(O + (size_t)row * 1024 + c0 + bj * 128 + (MODE == 2 ? (ai * 4 + m) * 0 : 0), acc[ai][bj][m][0], acc[ai][bj][m][1]); }
    } };
struct EpiSsqOnly { static constexpr int MID_T = 0; float* SSQ;
    __device__ __forceinline__ void operator()(const AccT& acc, const Unit& u, int wr, int wc, int fr, int fq) const {
        const int row0 = u.pm * 256 + wr * 64 + fr;
#pragma unroll
        for (int ai = 0; ai < 2; ++ai)
#pragma unroll
            for (int m = 0; m < 4; ++m) { const int row = row0 + ai * 128 + m * 16; float s = 0.f;
#pragma unroll
                for (int bj = 0; bj < 2; ++bj) s += ssq4(acc[ai][bj][m][0]) + ssq4(acc[ai][bj][m][1]);
                s += __shfl_xor(s, 16); s += __shfl_xor(s, 32); if (fq == 0) SSQ[(size_t)row * 16 + u.pn * 4 + wc] = s; }
    } };
struct EpiUp {
    static constexpr int MID_T = 0;
    bf16* ACT; float* SB; const float* cw; const float* cb;
    __device__ __forceinline__ void operator()(AccT& acc, const Unit& u, int wr, int wc, int fr, int fq) const {
        const int lane = fq * 16 + fr;
        const int src_prev = ((lane & 48) | ((fr + 15) & 15)) << 2, src_next = ((lane & 48) | ((fr + 1) & 15)) << 2; (void)src_prev; (void)src_next;
        const int bat = u.pm / 17, tin = u.pm % 17;
        const int colw = wc * 32 + fq * 8;
        const bool lo = fr < 2, bnd = lo || fr >= 14; const int which = lo ? fr : fr - 12;
        const bool f0 = (fr == 0), f15 = (fr == 15); const LaneTr LT(fr, fq);
#pragma unroll
        for (int ai = 0; ai < 2; ++ai) {
            const int chunk = (bat * SEQ + (tin - 1) * 256 + ai * 128 + wr * 64) >> 6;
            if (bnd) {
                float* sb = SB + ((size_t)chunk * 4 + which) * DUP + u.pn * 256 + colw;
#pragma unroll
                for (int bj = 0; bj < 2; ++bj)
#pragma unroll
                    for (int n = 0; n < 2; ++n) *(GAS f32x4*)(sb + bj * 128 + n * 4) = lo ? acc[ai][bj][0][n] : acc[ai][bj][3][n];
            }
            const size_t rowb = (size_t)(u.pm * 256 + ai * 128 + wr * 64 + fr);
#pragma unroll
            for (int n = 0; n < 2; ++n) {
#pragma unroll
                for (int bj = 0; bj < 2; ++bj) {
                    asm volatile("" ::: "memory"); __builtin_amdgcn_sched_barrier(0);
                    const int oc = bj * DFF + u.pn * 128 + colw + n * 4;
                    const f32x4 w0 = *(const f32x4*)(cw + oc), w1 = *(const f32x4*)(cw + DUP + oc), w2 = *(const f32x4*)(cw + 2 * DUP + oc), bb = *(const f32x4*)(cb + oc);
                    const f32x4 a0 = acc[ai][bj][0][n], a1 = acc[ai][bj][1][n], a2 = acc[ai][bj][2][n], a3 = acc[ai][bj][3][n];
#ifdef CONV_BPERMUTE
                    const f32x4 p0 = bperm4(src_prev, a0), p1 = bperm4(src_prev, a1), p2 = bperm4(src_prev, a2), p3 = bperm4(src_prev, a3);
                    const f32x4 n0 = bperm4(src_next, a0), n1 = bperm4(src_next, a1), n2 = bperm4(src_next, a2), n3 = bperm4(src_next, a3);
#else
                    const f32x4 p0 = dpp4<DPP_PREV>(a0), p1 = dpp4<DPP_PREV>(a1), p2 = dpp4<DPP_PREV>(a2), p3 = dpp4<DPP_PREV>(a3);
                    const f32x4 n0 = dpp4<DPP_NEXT>(a0), n1 = dpp4<DPP_NEXT>(a1), n2 = dpp4<DPP_NEXT>(a2), n3 = dpp4<DPP_NEXT>(a3);
#endif
                    acc[ai][bj][0][n] = bb + w0 * sel4(f0, p3, p0) + w1 * a0 + w2 * sel4(f15, n1, n0);
                    acc[ai][bj][1][n] = bb + w0 * sel4(f0, p0, p1) + w1 * a1 + w2 * sel4(f15, n2, n1);
                    acc[ai][bj][2][n] = bb + w0 * sel4(f0, p1, p2) + w1 * a2 + w2 * sel4(f15, n3, n2);
                    acc[ai][bj][3][n] = bb + w0 * sel4(f0, p2, p3) + w1 * a3 + w2 * sel4(f15, n0, n3);
                }
            }
            asm volatile("" ::: "memory"); __builtin_amdgcn_sched_barrier(0);
#pragma unroll
            for (int m = 0; m < 4; ++m) {
                f32x4 o0, o1;
#pragma unroll
                for (int i = 0; i < 4; ++i) { o0[i] = silu_f(acc[ai][0][m][0][i]) * acc[ai][1][m][0][i]; o1[i] = silu_f(acc[ai][0][m][1][i]) * acc[ai][1][m][1][i]; }
                st8c<TR_FUP>(ACT, DFF, u.pm * 256 + ai * 128 + wr * 64 + m * 16, u.pn * 128 + wc * 32, LT, o0, o1);
            }
        }
    }
};
__device__ __forceinline__ void p4_attention(const Args& a, char* lds, int vcu, int G, int tid) {
    unsigned char* ws = a.ws;
    const bf16* QN = (const bf16*)(ws + WS_QN); const bf16* QR = (const bf16*)(ws + WS_QR); const bf16* KN = (const bf16*)(ws + WS_KN); const bf16* KR = (const bf16*)(ws + WS_KR); const bf16* VM = (const bf16*)(ws + WS_VM);
    const bf16* QS = (const bf16*)(ws + WS_QS); const bf16* KS = (const bf16*)(ws + WS_KS); const bf16* VS = (const bf16*)(ws + WS_VS); bf16* O2 = (bf16*)(ws + WS_H);
#ifndef REP_MLA
#define REP_MLA 1
#endif
#ifndef REP_SWA
#define REP_SWA 1
#endif
    for (int unit = vcu; unit < 1024 * REP_MLA; unit += G) {
        const int bh = (unit & 1023) >> 4, qb = unit & 15, b = bh >> 3, h = bh & 7;
        const size_t krow0 = (size_t)b * TPB, qrow0 = krow0 + CTX + qb * 256;
        att::AttnIO io;
        io.Q1 = QN + qrow0 * 512 + h * 64; io.Q2 = QR + qrow0 * 256 + h * 32;
        io.K1 = KN + krow0 * 512 + h * 64; io.K2 = KR + krow0 * 32;
        io.V = VM + krow0 * 512 + h * 64; io.O = O2 + qrow0 * 1024 + h * 64;
        att::attn_unit<false>(io, qb * 256, 0.f, lds, tid);
    }
#ifdef XVAR
    for (int unit = vcu; unit < 1024; unit += G) {
        const int bh = unit >> 4, qb = unit & 15, b = bh >> 3, h = bh & 7;
        const size_t krow0 = (size_t)b * TPB, qrow0 = krow0 + CTX + qb * 256;
        att::AttnIO io;
        io.Q1 = QN + qrow0 * 512 + h * 64; io.Q2 = QR + qrow0 * 256 + h * 32;
        io.K1 = KN + krow0 * 512 + h * 64; io.K2 = KR + krow0 * 32;
        io.V = VM + krow0 * 512 + h * 64; io.O = (bf16*)(ws + WS_F) + qrow0 * 1024 + h * 64;
        att::attn_unit<false, XVAR>(io, qb * 256, 0.f, lds, tid);
    }
#endif
    for (int unit = vcu; unit < 1024 * REP_SWA; unit += G) {
        const int bh = (unit & 1023) >> 4, qb = unit & 15, b = bh >> 3, h = bh & 7, kvh = h >> 2;
        const size_t krow0 = (size_t)b * TPB, qrow0 = krow0 + CTX + qb * 256;
        att::AttnIO io;
        io.Q1 = QS + qrow0 * 512 + h * 64; io.Q2 = nullptr;
        io.K1 = KS + krow0 * 128 + kvh * 64; io.K2 = nullptr;
        io.V = VS + krow0 * 128 + kvh * 64; io.O = O2 + qrow0 * 1024 + 512 + h * 64;
        att::attn_unit<true>(io, qb * 256, a.in[I_SINK][h], lds, tid);
    }
}
__device__ __forceinline__ void p7_resid_norm(const Args& a, LAS unsigned char* lds, int vcu, int G, int tid, int lane, int wave) {
    unsigned char* ws = a.ws; const float* MODF = (const float*)(ws + WS_MODF); const bf16* AL = (const bf16*)(ws + WS_AL); const float* SSQ = (const float*)(ws + WS_SSQ_16); bf16* HF = (bf16*)(ws + WS_H);
    LAS float* vpg = (LAS float*)lds; LAS float* vg1 = vpg + 1024; LAS float* vfg = vg1 + 1024; LAS float* vsh = vfg + 1024; LAS float* vsc = vsh + 1024;
    const int rows_per = (RL + G - 1) / G;
    int r = vcu * rows_per; const int rend = (r + rows_per < RL) ? r + rows_per : RL;
    while (r < rend) {
        const int b = r / SEQ; const int seg_end = (b + 1) * SEQ; const int e = seg_end < rend ? seg_end : rend;
        __syncthreads();
        for (int j = tid; j < 1024; j += 512) { vpg[j] = a.in[I_APOST][j]; vg1[j] = MODF[b * 6144 + 2048 + j]; vfg[j] = a.in[I_FPRE][j]; vsh[j] = MODF[b * 6144 + 3072 + j]; vsc[j] = 1.f + MODF[b * 6144 + 4096 + j]; }
        __syncthreads();
        for (int rl = r + wave; rl < e; rl += NWAVES) {
            const size_t row = (size_t)b * TPB + CTX + (rl - b * SEQ);
            const f32x4* sp = (const f32x4*)(SSQ + row * 16); const f32x4 s0 = sp[0], s1 = sp[1], s2 = sp[2], s3 = sp[3];
            const float ssq = ((s0[0] + s0[1]) + (s0[2] + s0[3])) + ((s1[0] + s1[1]) + (s1[2] + s1[3])) + ((s2[0] + s2[1]) + (s2[2] + s2[3])) + ((s3[0] + s3[1]) + (s3[2] + s3[3]));
            const float rstd1 = 1.f / sqrtf(ssq * (1.f / 1024.f) + EPS);
            const GAS f32x4* xr = (const GAS f32x4*)(a.in[I_X] + (size_t)rl * 1024) + lane; GAS f32x4* xo = (GAS f32x4*)(a.out + (size_t)rl * 1024) + lane;
            const GAS v2u* ar = (const GAS v2u*)(AL + row * 1024) + lane;
            f32x4 v[4]; float s = 0.f;
#pragma unroll
            for (int j = 0; j < 4; ++j) { const int c0 = 4 * lane + 256 * j; const f32x4 x = NTL(xr + 64 * j); const f32x4 al = unpk4(NTL(ar + 64 * j));
#pragma unroll
                for (int i = 0; i < 4; ++i) v[j][i] = x[i] + vg1[c0 + i] * (al[i] * rstd1 * vpg[c0 + i]);
                NTS(v[j], xo + 64 * j); s += ssq4(v[j]); }
            const float rstd2 = 1.f / sqrtf(wave_sum(s) * (1.f / 1024.f) + EPS);
            GAS v2u* o8 = (GAS v2u*)(HF + row * 1024) + lane;
#pragma unroll
            for (int j = 0; j < 4; ++j) { const int c0 = 4 * lane + 256 * j; f32x4 o;
#pragma unroll
                for (int i = 0; i < 4; ++i) o[i] = (v[j][i] * rstd2 * vfg[c0 + i]) * vsc[c0 + i] + vsh[c0 + i];
                NTS(pk4(o), o8 + 64 * j); }
        }
        r = e;
    }
    __syncthreads();
}
__device__ __forceinline__ void p9_conv_fix(const Args& a, int vcu, int G, int lane, int wave) {
    unsigned char* ws = a.ws; const float* SB = (const float*)(ws + WS_SB); bf16* ACT = (bf16*)(ws + WS_ACT); const float* cw = a.in[I_CONVW]; const float* cb = a.in[I_CONVB];
    const int gw = vcu * NWAVES + wave, NGW = G * NWAVES;
    for (int task = gw; task < 2 * 512; task += NGW) {
        const int chunk = task >> 1, last = task & 1;
        const int t = chunk * 64 + (last ? 63 : 0);
        const int b = t / SEQ, pos = t % SEQ; const size_t row = (size_t)b * TPB + CTX + pos;
        const float* cur = SB + ((size_t)chunk * 4 + (last ? 3 : 0)) * DUP;
        const float* prv = last ? SB + ((size_t)chunk * 4 + 2) * DUP : (pos == 0 ? nullptr : SB + ((size_t)(chunk - 1) * 4 + 3) * DUP);
        const float* nxt = last ? (pos == SEQ - 1 ? nullptr : SB + ((size_t)(chunk + 1) * 4 + 0) * DUP) : SB + ((size_t)chunk * 4 + 1) * DUP;
        for (int cc = lane; cc < DFF; cc += 64) {
            const int pg = (cc >> 7) * 256 + (cc & 127), pv = pg + 128;
            const float gp = prv ? prv[pg] : 0.f, gc = cur[pg], gn = nxt ? nxt[pg] : 0.f, vp = prv ? prv[pv] : 0.f, vc = cur[pv], vn = nxt ? nxt[pv] : 0.f;
            const float ug = cb[cc] + cw[cc] * gp + cw[DUP + cc] * gc + cw[2 * DUP + cc] * gn;
            const float uv = cb[DFF + cc] + cw[DFF + cc] * vp + cw[DUP + DFF + cc] * vc + cw[2 * DUP + DFF + cc] * vn;
            ACT[row * DFF + cc] = (bf16)(pk2(silu_f(ug) * uv, 0.f) & 0xffffu);
        }
    }
}
#ifndef EXP_FFN_SCALE
#define EXP_FFN_SCALE 1.f
#endif
__device__ __forceinline__ void p11_final(const Args& a, LAS unsigned char* lds, int vcu, int G, int tid, int lane, int wave) {
    unsigned char* ws = a.ws; const float* MODF = (const float*)(ws + WS_MODF); const bf16* F = (const bf16*)(ws + WS_F); const float* SSQ = (const float*)(ws + WS_SSQ_16);
    LAS float* vpg = (LAS float*)lds; LAS float* vg2 = vpg + 1024;
    const int rows_per = (RL + G - 1) / G;
    int r = vcu * rows_per; const int rend = (r + rows_per < RL) ? r + rows_per : RL;
    while (r < rend) {
        const int b = r / SEQ; const int seg_end = (b + 1) * SEQ; const int e = seg_end < rend ? seg_end : rend;
        __syncthreads();
        for (int j = tid; j < 1024; j += 512) { vpg[j] = a.in[I_FPOST][j]; vg2[j] = MODF[b * 6144 + 5120 + j]; }
        __syncthreads();
        for (int rl = r + wave; rl < e; rl += NWAVES) {
            const size_t row = (size_t)b * TPB + CTX + (rl - b * SEQ);
            const f32x4* sp = (const f32x4*)(SSQ + row * 16); const f32x4 s0 = sp[0], s1 = sp[1], s2 = sp[2], s3 = sp[3];
            const float ssq = ((s0[0] + s0[1]) + (s0[2] + s0[3])) + ((s1[0] + s1[1]) + (s1[2] + s1[3])) + ((s2[0] + s2[1]) + (s2[2] + s2[3])) + ((s3[0] + s3[1]) + (s3[2] + s3[3]));
            const float rstd = 1.f / sqrtf(ssq * (1.f / 1024.f) + EPS);
            GAS f32x4* xo = (GAS f32x4*)(a.out + (size_t)rl * 1024) + lane; const GAS v2u* fr_ = (const GAS v2u*)(F + row * 1024) + lane;
#pragma unroll
            for (int j = 0; j < 4; ++j) { const int c0 = 4 * lane + 256 * j; f32x4 x = NTL(xo + 64 * j); const f32x4 f = unpk4(NTL(fr_ + 64 * j));
#pragma unroll
                for (int i = 0; i < 4; ++i) x[i] = x[i] + EXP_FFN_SCALE * vg2[c0 + i] * (f[i] * rstd * vpg[c0 + i]);
                NTS(x, xo + 64 * j); }
        }
        r = e;
    }
}

__device__ __forceinline__ int lane_id_volatile() { int l; asm volatile("v_mbcnt_lo_u32_b32 %0, -1, 0\n\tv_mbcnt_hi_u32_b32 %0, -1, %0" : "=v"(l)); return l; }

#ifdef DEBUG_FFN
constexpr int DBG_W = 8192;
__device__ __forceinline__ unsigned dbg_hash(unsigned x) { x ^= x >> 16; x *= 0x7feb352du; x ^= x >> 15; x *= 0x846ca68bu; x ^= x >> 16; return x; }
__device__ __forceinline__ void dbg_check_act(const Args& a, int vcu, int G, int lane, int wave) {
    unsigned char* ws = a.ws; const bf16* HF = (const bf16*)(ws + WS_H); const bf16* ACT = (const bf16*)(ws + WS_ACT); unsigned* ctl = (unsigned*)(ws + WS_CTL);
    const float* wup = a.in[I_WUP]; const float* cw = a.in[I_CONVW]; const float* cb = a.in[I_CONVB];
    const int s = vcu * NWAVES + wave;
    const unsigned h1 = dbg_hash(s * 3 + 1), h2 = dbg_hash(s * 3 + 2), h3 = dbg_hash(s * 3 + 3);
    const int type = s % 5, chunk = h1 % 512;
    int ric = 0;
    if (type == 0) ric = 16 * (h2 % 4) + 1 + (h3 % 14); else if (type == 1) ric = 16 * (1 + h2 % 3); else if (type == 2) ric = 16 * (h2 % 3) + 15; else if (type == 3) ric = 0; else ric = 63;
    const int t = chunk * 64 + ric, b = t / SEQ, pos = t % SEQ, cc = (h3 >> 8) % DFF;
    float ug = cb[cc], uv = cb[DFF + cc];
    for (int j = 0; j < 3; ++j) {
        const int pp = pos + j - 1; if (pp < 0 || pp >= SEQ) continue;
        const bf16* hr = HF + ((size_t)b * TPB + CTX + pp) * 1024;
        float sg = 0.f, sv = 0.f;
        for (int k = lane; k < 1024; k += 64) { const float hv = bf2f(hr[k]); sg += hv * wup[(size_t)k * DUP + cc]; sv += hv * wup[(size_t)k * DUP + DFF + cc]; }
        sg = wave_sum(sg); sv = wave_sum(sv);
        ug += cw[j * DUP + cc] * sg; uv += cw[j * DUP + DFF + cc] * sv;
    }
    const float ref = silu_f(ug) * uv; const float got = bf2f(ACT[((size_t)b * TPB + CTX + pos) * DFF + cc]);
    const float d = fabsf(ref - got);
    if (lane == 0) { if (d > 0.03f + 0.03f * fabsf(ref)) atomicOr(ctl + DBG_W, 1u << type); atomicMax(ctl + DBG_W + 1, (unsigned)(d * 1000.f)); }
}
#endif
__global__ void __launch_bounds__(NWAVES * 64, 2) fwd_kernel(Args args) {
    extern __shared__ __attribute__((aligned(16))) unsigned char lds_raw[];
    LAS unsigned char* lds = (LAS unsigned char*)lds_raw;
    volatile LAS unsigned* MISC = (volatile LAS unsigned*)(lds + MISC_OFF);
    const int tid0 = threadIdx.x; const int wave0 = __builtin_amdgcn_readfirstlane(tid0 >> 6);
#define TID() (wave0 * 64 + lane_id_volatile())
    const int G = gridDim.x; const int bx = blockIdx.x; const int vcu = (G % 8 == 0) ? (bx % 8) * (G / 8) + bx / 8 : bx;
    unsigned char* ws = args.ws;
    for (int u = tid0; u < (LDS_BYTES - RING_BYTES) / 4; u += NWAVES * 64) ((LAS unsigned*)(lds + RING_BYTES))[u] = 0u;
    __syncthreads();
    XcdBarrier bar = xcd_barrier_post((unsigned*)(ws + WS_CTL), MISC + 8);
#define GRID_BAR() xcd_barrier(bar)
#ifndef STG2
#define STG2 0
#define STG8 0
#endif
    const int odd_cu = (bx >> 3) & 1;
#ifndef REP_PHASE
#define REP_PHASE -1
#endif
#ifndef REP_COUNT
#define REP_COUNT 2
#endif
#define REPS(n) ((n) == REP_PHASE ? REP_COUNT : 1)
    bf16* H = (bf16*)(ws + WS_H);
#define PH(n) (!defined(ONLY) || ONLY == (n))
    asm volatile("; PHASE_MARK 0");
#if !defined(ONLY) || ONLY == 0
    for (int rep_ = 0; rep_ < REPS(0); ++rep_) { if (rep_) GRID_BAR();
    { int tid = TID(); asm volatile("" : "+v"(tid)); const int lane = tid & 63, wave = __builtin_amdgcn_readfirstlane(tid >> 6); p0_prologue(args, lds, vcu, G, tid, lane, wave); }
    }
#endif
    GRID_BAR();
    asm volatile("; PHASE_MARK 1");
#if !defined(ONLY) || ONLY == 1
    for (int rep_ = 0; rep_ < REPS(1); ++rep_) { if (rep_) GRID_BAR();
    { int tid = TID(); asm volatile("" : "+v"(tid)); const int lane = tid & 63, wave = __builtin_amdgcn_readfirstlane(tid >> 6); p1_norm_mod(args, lds, vcu, G, tid, lane, wave); }
    }
#endif
    GRID_BAR();
    asm volatile("; PHASE_MARK 2");
#if !defined(ONLY) || ONLY == 2
    for (int rep_ = 0; rep_ < REPS(2); ++rep_) { if (rep_) GRID_BAR();
    {
        pg8::Gemm g{H, (const bf16*)(ws + WS_WIN), 1024, 1024, 1024}; pg8::Order<2> S{13, G, bx};
        EpiInProj E{(bf16*)(ws + WS_QA), (bf16*)(ws + WS_KVR), (bf16*)(ws + WS_KR), (bf16*)(ws + WS_KS), (bf16*)(ws + WS_VS), (bf16*)(ws + WS_QS), (unsigned char*)(ws + WS_G),
                    (float*)(ws + WS_SSQ_Q), (float*)(ws + WS_SSQ_KV), args.in[I_BGATE], (const float2*)(ws + WS_ROPE_S), (const float2*)(ws + WS_ROPE_M)};
        pg8::gemm_phase(lds, g, S, E, TID(), odd_cu * STG2);
    }
    }
#endif
    GRID_BAR();
    asm volatile("; PHASE_MARK 3");
#if !defined(ONLY) || ONLY == 3
    for (int rep_ = 0; rep_ < REPS(3); ++rep_) { if (rep_) GRID_BAR();
    {
        static_assert(WS_KVR == WS_QA + (size_t)RT * 256 * 2 && WS_WKV == WS_WQ + 768 * 256 * 2, "up-projection operands must be contiguous");
        pg8::Gemm g{(const bf16*)(ws + WS_QA), (const bf16*)(ws + WS_WQ), 256, 256, 256}; pg8::Order<3> S{0, G, bx};
        EpiUp3 E{EpiQUp{(bf16*)(ws + WS_QN), (bf16*)(ws + WS_QR), (const float*)(ws + WS_SSQ_Q), (const float2*)(ws + WS_ROPE_M)},
                 EpiKVUp{(bf16*)(ws + WS_KN), (bf16*)(ws + WS_VM), (const float*)(ws + WS_SSQ_KV)}};
        pg8::gemm_phase(lds, g, S, E, TID());
    }
    }
#endif
    GRID_BAR();
    asm volatile("; PHASE_MARK 4");
#if !defined(ONLY) || ONLY == 4
    for (int rep_ = 0; rep_ < REPS(4); ++rep_) { if (rep_) GRID_BAR();
    p4_attention(args, (char*)lds_raw, vcu, G, TID());
    }
#endif
    GRID_BAR();
    asm volatile("; PHASE_MARK 5");
#if !defined(ONLY) || ONLY == 5
    for (int rep_ = 0; rep_ < REPS(5); ++rep_) { if (rep_) GRID_BAR();
    {
        pg8::Gemm g{H, (const bf16*)(ws + WS_WOAB), 1024, 1024, 1024}; pg8::Order<1> S{4, G, bx};
        EpiMerge E{(bf16*)(ws + WS_M1b), (const unsigned char*)(ws + WS_G)};
        pg8::gemm_phase(lds, g, S, E, TID());
    }
    }
#endif
    GRID_BAR();
    asm volatile("; PHASE_MARK 6");
#if !defined(ONLY) || ONLY == 6
    for (int rep_ = 0; rep_ < REPS(6); ++rep_) { if (rep_) GRID_BAR();
    {
        pg8::Gemm g{(const bf16*)(ws + WS_M1b), (const bf16*)(ws + WS_WOUT), 1024, 1024, 1024}; pg8::Order<1> S{4, G, bx};
        EpiOutSsq E{(bf16*)(ws + WS_AL), (float*)(ws + WS_SSQ_16)};
        pg8::gemm_phase(lds, g, S, E, TID());
    }
    }
#endif
#ifdef XP6
    {
        pg8::Gemm g{(const bf16*)(ws + WS_M1b), (const bf16*)(ws + WS_WOUT), 1024, 1024, 1024}; pg8::Order<1> S{4, G, bx};
#if XP6 == 2
        EpiNull E{(float*)(ws + WS_F)};
#elif XP6 == 3
        EpiStoreOnly E{(bf16*)(ws + WS_F)};
#elif XP6 == 5
        EpiStoreX<1> E{(bf16*)(ws + WS_F)};
#elif XP6 == 6
        EpiStoreX<2> E{(bf16*)(ws + WS_F)};
#elif XP6 == 4
        EpiSsqOnly E{(float*)(ws + WS_F) + 20 * 1024 * 1024};
#else
        EpiOutSsq E{(bf16*)(ws + WS_F), (float*)(ws + WS_F) + 20 * 1024 * 1024};
#endif
        pg8::gemm_phase(lds, g, S, E, TID());
    }
#endif
    GRID_BAR();
    asm volatile("; PHASE_MARK 7");
#if !defined(ONLY) || ONLY == 7
    for (int rep_ = 0; rep_ < REPS(7); ++rep_) { if (rep_) GRID_BAR();
    { int tid = TID(); asm volatile("" : "+v"(tid)); const int lane = tid & 63, wave = __builtin_amdgcn_readfirstlane(tid >> 6); p7_resid_norm(args, lds, vcu, G, tid, lane, wave); }
    }
#endif
    GRID_BAR();
    asm volatile("; PHASE_MARK 8");
#if !defined(ONLY) || ONLY == 8
    for (int rep_ = 0; rep_ < REPS(8); ++rep_) { if (rep_) GRID_BAR();
    {
        pg8::Gemm g{H, (const bf16*)(ws + WS_WUP), 1024, 1024, 1024}; pg8::Order<1> S{22, G, bx};
        EpiUp E{(bf16*)(ws + WS_ACT), (float*)(ws + WS_SB), args.in[I_CONVW], args.in[I_CONVB]};
        pg8::gemm_phase(lds, g, S, E, TID(), odd_cu * STG8);
    }
    }
#endif
    GRID_BAR();
    asm volatile("; PHASE_MARK 9");
#if !defined(ONLY) || ONLY == 9
    for (int rep_ = 0; rep_ < REPS(9); ++rep_) { if (rep_) GRID_BAR();
    { int tid = TID(); asm volatile("" : "+v"(tid)); const int lane = tid & 63, wave = __builtin_amdgcn_readfirstlane(tid >> 6); p9_conv_fix(args, vcu, G, lane, wave); }
    }
#endif
    GRID_BAR();
    asm volatile("; PHASE_MARK 10");
#if !defined(ONLY) || ONLY == 10
    for (int rep_ = 0; rep_ < REPS(10); ++rep_) { if (rep_) GRID_BAR();
    {
        pg8::Gemm g{(const bf16*)(ws + WS_ACT), (const bf16*)(ws + WS_WDN), DFF, DFF, DFF}; pg8::Order<1> S{4, G, bx};
        EpiOutSsq E{(bf16*)(ws + WS_F), (float*)(ws + WS_SSQ_16)};
        pg8::gemm_phase(lds, g, S, E, TID());
    }
    }
#endif
    GRID_BAR();
    asm volatile("; PHASE_MARK 11");
#ifdef DEBUG_FFN
    { int tid = TID(); asm volatile("" : "+v"(tid)); const int lane = tid & 63, wave = __builtin_amdgcn_readfirstlane(tid >> 6); dbg_check_act(args, vcu, G, lane, wave); }
    GRID_BAR();
#endif
#if !defined(ONLY) || ONLY == 11
    for (int rep_ = 0; rep_ < REPS(11); ++rep_) { if (rep_) GRID_BAR();
    { int tid = TID(); asm volatile("" : "+v"(tid)); const int lane = tid & 63, wave = __builtin_amdgcn_readfirstlane(tid >> 6); p11_final(args, lds, vcu, G, tid, lane, wave); }
    }
#endif
#ifdef DEBUG_FFN
    if (bx == 0 && TID() == 0) { unsigned* ctl = (unsigned*)(ws + WS_CTL); const unsigned mask = __hip_atomic_load(ctl + DBG_W, __ATOMIC_RELAXED, __HIP_MEMORY_SCOPE_AGENT), md = __hip_atomic_load(ctl + DBG_W + 1, __ATOMIC_RELAXED, __HIP_MEMORY_SCOPE_AGENT);
        float mant = 10.f + fminf(89.f, (float)md * 0.01f); float v = mant; for (unsigned i = 0; i < 4 + mask; ++i) v *= 10.f; args.out[0] = v; }
#endif
}

extern "C" void kernel_launch(void* const* d_in, const int* in_sizes, int n_in, void* d_out, int out_size, void* d_ws, size_t ws_size, hipStream_t stream) {
    static int grid = 0;
    if (grid == 0) {
        if (n_in != 24 || out_size != RL * DM || ws_size < 452 * MiB) { fprintf(stderr, "kernel_launch: unexpected shapes (n_in %d out %d ws %zu)\n", n_in, out_size, ws_size); grid = -1; return; }
        int dev = 0, cus = 0;
        if (hipGetDevice(&dev) != hipSuccess || hipDeviceGetAttribute(&cus, hipDeviceAttributeMultiprocessorCount, dev) != hipSuccess) { grid = -1; return; }
        if (hipFuncSetAttribute((const void*)fwd_kernel, hipFuncAttributeMaxDynamicSharedMemorySize, LDS_BYTES) != hipSuccess) { fprintf(stderr, "kernel_launch: hipFuncSetAttribute failed\n"); grid = -1; return; }
        int per_cu = 0;
        if (hipOccupancyMaxActiveBlocksPerMultiprocessor(&per_cu, (const void*)fwd_kernel, NWAVES * 64, LDS_BYTES) != hipSuccess || per_cu < 1) fprintf(stderr, "kernel_launch: occupancy query says %d\n", per_cu);
        (void)hipGetLastError();
        grid = cus;
    }
    if (grid < 0) return;
    if (hipMemsetAsync((char*)d_ws + WS_CTL, 0, CTL_ZERO_BYTES, stream) != hipSuccess) return;
    Args a{};
    for (int i = 0; i < 24; ++i) a.in[i] = (const float*)d_in[i];
    a.out = (float*)d_out; a.ws = (unsigned char*)d_ws;
    hipLaunchKernelGGL(fwd_kernel, dim3(grid), dim3(NWAVES * 64), LDS_BYTES, stream, a);
}
```
